# Optimizing an MI355X kernel written in HIP

```python
import jax, jax.numpy as jnp
from jax import lax
import numpy as np


D_MODEL = 1024
BATCH = 2
SEQ = 8192
DEPTH = 2

POOL_WINDOWS = (2, 4, 8, 16)
POOL_GROUPS = len(POOL_WINDOWS)
POOL_WIDTH = D_MODEL
POOL_GROUP = POOL_WIDTH // POOL_GROUPS
SGU_CHUNK = 128
SGU_WIDTH = D_MODEL
SGU_HEADS = 8
SGU_HEAD_DIM = SGU_WIDTH // SGU_HEADS
N_BRANCHES = 2
IN_WIDTH = POOL_WIDTH + 2 * SGU_WIDTH + N_BRANCHES * D_MODEL
D_FF = 2816
CONV_WIDTH = 3
PLE_DIM = 256
EPS = 1e-6

kernel_name = "hybrid_pool_sgu_convffn_ple"


def rmsnorm(x, g):
    xf = x.astype(jnp.float32)
    y = xf * lax.rsqrt(jnp.mean(xf * xf, axis=-1, keepdims=True) + EPS)
    return (y * g.astype(jnp.float32)).astype(x.dtype)


def pool_mixer(h, w_pool, pool_scale):
    T = h.shape[1]
    hf = h.astype(jnp.float32)
    c = jnp.cumsum(hf, axis=1)
    t = jnp.arange(T)
    outs = []
    for gi, w in enumerate(POOL_WINDOWS):
        sl = slice(gi * POOL_GROUP, (gi + 1) * POOL_GROUP)
        cg = c[..., sl]
        prev = jnp.pad(cg, ((0, 0), (w, 0), (0, 0)))[:, :T]
        cnt = jnp.minimum(t + 1, w).astype(jnp.float32)[None, :, None]
        outs.append((cg - prev) / cnt - hf[..., sl])
    pooled = jnp.stack(outs, axis=2).astype(h.dtype)
    y = jnp.einsum('btgc,gcd->btgd', pooled, w_pool)
    return y.reshape(h.shape) * pool_scale


def spatial_gating(z_uv, sgu_norm, w_spatial, b_spatial):
    B, T, _ = z_uv.shape
    z = jax.nn.gelu(z_uv, approximate=False)
    u, v = z[..., :SGU_WIDTH], z[..., SGU_WIDTH:]
    v = rmsnorm(v, sgu_norm)
    nc = T // SGU_CHUNK
    v = v.reshape(B, nc, SGU_CHUNK, SGU_HEADS, SGU_HEAD_DIM)
    mask = jnp.tril(jnp.ones((SGU_CHUNK, SGU_CHUNK), dtype=w_spatial.dtype))
    ws = w_spatial * mask[None]
    mixed = jnp.einsum('hts,bnshd->bnthd', ws, v)
    mixed = mixed + jnp.transpose(b_spatial)[None, None, :, :, None]
    return u * mixed.reshape(B, T, SGU_WIDTH)


def conv_ffn(h, w_up, conv_w, conv_b, w_down):
    T = h.shape[1]
    up = h @ w_up
    up_pad = jnp.pad(up, ((0, 0), (CONV_WIDTH - 1, 0), (0, 0)))
    conv = conv_b
    for k in range(CONV_WIDTH):
        conv = conv + conv_w[k] * up_pad[:, k:k + T]
    a, b = conv[..., :D_FF], conv[..., D_FF:]
    return (jax.nn.gelu(a, approximate=False) * b) @ w_down


def setup_inputs(seed: int = 0) -> dict:
    key = jax.random.key(seed)
    ks = jax.random.split(key, 24)
    f32 = jnp.float32
    L, D = DEPTH, D_MODEL

    def nrm(k, shape, scale):
        return jax.random.normal(k, shape, f32) * scale

    def gain(k, shape):
        return 1.0 + 0.05 * jax.random.normal(k, shape, f32)

    return {
        "x": nrm(ks[0], (BATCH, SEQ, D), 1.0),
        "p": nrm(ks[1], (DEPTH, BATCH, SEQ, PLE_DIM), 1.0),
        "mix_norm": gain(ks[2], (L, D)),
        "w_in": nrm(ks[3], (L, D, IN_WIDTH), D ** -0.5),
        "w_pool": nrm(ks[4], (L, POOL_GROUPS, POOL_GROUP, POOL_GROUP), POOL_GROUP ** -0.5),
        "pool_scale": gain(ks[5], (L, POOL_WIDTH)),
        "sgu_norm": gain(ks[6], (L, SGU_WIDTH)),
        "w_spatial": nrm(ks[7], (L, SGU_HEADS, SGU_CHUNK, SGU_CHUNK), 0.5 * SGU_CHUNK ** -0.5),
        "b_spatial": gain(ks[8], (L, SGU_HEADS, SGU_CHUNK)),
        "w_branch_a": nrm(ks[9], (L, POOL_WIDTH, D), POOL_WIDTH ** -0.5),
        "w_branch_b": nrm(ks[10], (L, SGU_WIDTH, D), SGU_WIDTH ** -0.5),
        "w_out": nrm(ks[11], (L, D, D), D ** -0.5),
        "ffn_norm": gain(ks[12], (L, D)),
        "w_up": nrm(ks[13], (L, D, 2 * D_FF), D ** -0.5),
        "conv_w": nrm(ks[14], (L, CONV_WIDTH, 2 * D_FF), CONV_WIDTH ** -0.5),
        "conv_b": nrm(ks[15], (L, 2 * D_FF), 0.02),
        "w_down": nrm(ks[16], (L, D_FF, D), D_FF ** -0.5),
        "ple_norm": gain(ks[17], (L, D)),
        "w_ple_gate": nrm(ks[18], (L, D, D), D ** -0.5),
        "w_ple": nrm(ks[19], (L, PLE_DIM, D), PLE_DIM ** -0.5),
        "final_norm": gain(ks[20], (D,)),
    }


def reference(x, p, mix_norm, w_in, w_pool, pool_scale, sgu_norm, w_spatial, b_spatial,
              w_branch_a, w_branch_b, w_out, ffn_norm, w_up, conv_w, conv_b, w_down,
              ple_norm, w_ple_gate, w_ple, final_norm):
    o_uv = POOL_WIDTH
    o_gate = POOL_WIDTH + 2 * SGU_WIDTH
    for i in range(DEPTH):
        h = rmsnorm(x, mix_norm[i])
        z = h @ w_in[i]
        z_pool = z[..., :o_uv]
        z_uv = z[..., o_uv:o_gate]
        z_gate = z[..., o_gate:]
        y_a = pool_mixer(z_pool, w_pool[i], pool_scale[i]) @ w_branch_a[i]
        y_b = spatial_gating(z_uv, sgu_norm[i], w_spatial[i], b_spatial[i]) @ w_branch_b[i]
        gates = jax.nn.sigmoid(z_gate.astype(jnp.float32)).astype(x.dtype)
        g_a, g_b = gates[..., :D_MODEL], gates[..., D_MODEL:]
        x = x + (g_a * y_a + g_b * y_b) @ w_out[i]
        h = rmsnorm(x, ffn_norm[i])
        x = x + conv_ffn(h, w_up[i], conv_w[i], conv_b[i], w_down[i])
        gate = jax.nn.sigmoid((rmsnorm(x, ple_norm[i]) @ w_ple_gate[i]).astype(jnp.float32)).astype(x.dtype)
        x = x + gate * (p[i] @ w_ple[i])
    return rmsnorm(x, final_norm)
```

```cpp
#include <hip/hip_runtime.h>
#include <hip/hip_cooperative_groups.h>
#include <cstdio>
#include <cstdint>
namespace cg = cooperative_groups;

#define LAS __attribute__((address_space(3)))
typedef unsigned short bf16_t;
typedef short bf16x8 __attribute__((ext_vector_type(8)));
typedef float f32x4 __attribute__((ext_vector_type(4)));
typedef float f32x2 __attribute__((ext_vector_type(2)));
typedef unsigned u32x4 __attribute__((ext_vector_type(4)));
typedef unsigned u32x2 __attribute__((ext_vector_type(2)));

constexpr int M = 16384, SEQ = 8192, D = 1024, NIN = 5120, FF = 2816, NUP = 5632, PLE = 256;
constexpr float EPS = 1e-6f;
constexpr size_t MiB = 1u << 20;
constexpr size_t WS_SSQA = 0, WS_SSQB = 1 * MiB, WS_SSQV = 2 * MiB;
constexpr size_t WS_CTL = 3 * MiB, CTL_BYTES = 16384;
constexpr size_t WS_W = 4 * MiB;
constexpr size_t W_IN = WS_W, W_POOL = W_IN + (size_t)NIN * D * 2, W_A = W_POOL + (size_t)D * 256 * 2, W_B = W_A + (size_t)D * D * 2, W_O = W_B + (size_t)D * D * 2,
                 W_UP = W_O + (size_t)D * D * 2, W_DN = W_UP + (size_t)NUP * D * 2, W_PG = W_DN + (size_t)D * FF * 2, W_PLE = W_PG + (size_t)D * D * 2, W_S16 = W_PLE + (size_t)D * PLE * 2,
                 W_END = W_S16 + (size_t)8 * 128 * 128 * 2;
constexpr size_t WS_XB = 40 * MiB, WS_BIG = 72 * MiB, WS_END = 256 * MiB;
static_assert(W_END <= WS_XB, "weights fit");
constexpr size_t WS_Z = WS_BIG;
constexpr size_t WS_UPP = WS_BIG, WS_ACT = WS_BIG + 96 * MiB;
constexpr size_t WS_PB = WS_BIG, WS_C32 = WS_BIG + 8 * MiB;
__device__ __forceinline__ size_t ws_big(int l) { return (size_t)(l == 0 ? 72 : 40) * MiB; }
__device__ __forceinline__ size_t ws_xb(int l) { return (size_t)(l == 0 ? 40 : 224) * MiB; }
static_assert(WS_ACT + (size_t)M * FF * 2 <= WS_END && WS_Z + (size_t)M * NIN * 2 <= WS_END && WS_C32 + (size_t)M * D * 4 <= WS_ACT, "map");

constexpr int LDS_BYTES = 147456;

enum { MODE_IN = 0, MODE_POOL, MODE_YA, MODE_YB, MODE_RES, MODE_UP, MODE_E, MODE_PLE };

typedef __bf16 bf16x2_t __attribute__((ext_vector_type(2)));
__device__ __forceinline__ unsigned cvt_pk_bf16(float lo, float hi) { f32x2 v = {lo, hi}; bf16x2_t b = __builtin_convertvector(v, bf16x2_t); return __builtin_bit_cast(unsigned, b); }
__device__ __forceinline__ float bf_lo(unsigned w) { return __uint_as_float(w << 16); }
__device__ __forceinline__ float bf_hi(unsigned w) { return __uint_as_float(w & 0xffff0000u); }
__device__ __forceinline__ f32x2 gelu_pk(f32x2 v) {
    const f32x2 av = __builtin_elementwise_abs(v), d = av * 0.2316418882f + 1.0f;
    f32x2 t; t.x = __builtin_amdgcn_rcpf(d.x); t.y = __builtin_amdgcn_rcpf(d.y);
    f32x2 q = t * 0.5307027145f + (-0.7265760135f); q = q * t + 0.7107068705f; q = q * t + (-0.142248368f); q = q * t + 0.127414796f; q = q * t;
    const f32x2 s = (v * v) * (-0.72134752044f);
    f32x2 e; e.x = __builtin_amdgcn_exp2f(s.x); e.y = __builtin_amdgcn_exp2f(s.y);
    const f32x2 m = v * (q * e), r = v - m;
    f32x2 o; o.x = v.x < 0.f ? m.x : r.x; o.y = v.y < 0.f ? m.y : r.y; return o;
}
__device__ __forceinline__ float gelu1(float v) { f32x2 r = gelu_pk((f32x2){v, v}); return r.x; }
__device__ __forceinline__ float sigm(float v) { return __builtin_amdgcn_rcpf(1.0f + __builtin_amdgcn_exp2f(-1.44269504089f * v)); }
__device__ __forceinline__ float wave_sum(float v) {
#pragma unroll
    for (int o = 1; o < 64; o <<= 1) v += __shfl_xor(v, o);
    return v;
}

constexpr int BM = 256, BK = 64, HALF = 128, HTB = HALF * BK * 2;
__device__ __forceinline__ int lds_byte(int r, int c) { const int st = (r >> 4) * 2 + (c >> 5), rr = r & 15, cc = c & 31, ob = rr * 64 + cc * 2; return st * 1024 + (ob ^ (((ob >> 9) & 1) << 5)); }
__device__ __forceinline__ void stage_rc(int b, int& R, int& C) { const int st = b / 1024, sb = b % 1024, swz = sb ^ (((sb >> 9) & 1) << 5); R = (st >> 1) * 16 + swz / 64; C = (st & 1) * 32 + (swz % 64) / 2; }
__device__ __forceinline__ int perm32(int rho) { const int n = rho >> 4, i = rho & 15; return 8 * (i >> 2) + 4 * n + (i & 3); }

struct Unit { const char* a; const char* b; int lda, ldb, nt, mode, pm, pn; };
struct SubG { const bf16_t* A; const bf16_t* B; int lda, ldb, K, mode, a_pn, bsplit, bjump; };
struct Sched {
    SubG s0, s1; int nsub, nN, G, c;
    __device__ __forceinline__ bool next(int i, Unit& u) const {
        const int sub = (nsub == 2) ? (i & 1) : 0, ii = (nsub == 2) ? (i >> 1) : i;
        const int nwg = 64 * nN; const long L = (long)ii * G + c; if (L >= nwg) return false;
        int wgid = (int)L; wgid = (wgid % 8) * (nwg / 8) + wgid / 8;
        const int nig = 8 * nN, gid = wgid / nig; const int pm = gid * 8 + ((wgid % nig) % 8), pn = (wgid % nig) / 8;
        const bf16_t* A = sub ? s1.A : s0.A; const bf16_t* B = sub ? s1.B : s0.B;
        const int lda = sub ? s1.lda : s0.lda, ldb = sub ? s1.ldb : s0.ldb, K = sub ? s1.K : s0.K, mode = sub ? s1.mode : s0.mode, a_pn = sub ? s1.a_pn : s0.a_pn,
                  bsplit = sub ? s1.bsplit : s0.bsplit, bjump = sub ? s1.bjump : s0.bjump;
        const int bt = pn < bsplit ? pn : pn + bjump;
        u.a = (const char*)(A + (size_t)pm * 256 * lda + (size_t)pn * a_pn); u.b = (const char*)(B + (size_t)bt * 256 * ldb);
        u.lda = lda; u.ldb = ldb; u.nt = K / BK; u.mode = mode; u.pm = pm; u.pn = pn; return true;
    }
};

struct Epi {
    bf16_t* Z; bf16_t* out16; int ld16;
    const float* ssq_in; float* ssq_out; float* ssqv;
    const bf16_t* xin16; bf16_t* xout16;
    const float* pool_scale; bf16_t* C16;
};
#define EPI_FENCE asm volatile("" ::: "memory")
__device__ __forceinline__ u32x4 pack8(const f32x4& v0, const f32x4& v1) { u32x4 w; w.x = cvt_pk_bf16(v0[0], v0[1]); w.y = cvt_pk_bf16(v0[2], v0[3]); w.z = cvt_pk_bf16(v1[0], v1[1]); w.w = cvt_pk_bf16(v1[2], v1[3]); return w; }
__device__ __forceinline__ float sumsq8(const f32x4& v0, const f32x4& v1) { return (v0[0] * v0[0] + v0[1] * v0[1]) + (v0[2] * v0[2] + v0[3] * v0[3]) + (v1[0] * v1[0] + v1[1] * v1[1]) + (v1[2] * v1[2] + v1[3] * v1[3]); }
__device__ __forceinline__ void epi_rstd(const float* ssq, int row0, int fq, float (&rs)[2][4]) {
    float part[2][4][4];
#pragma unroll
    for (int ai = 0; ai < 2; ++ai)
#pragma unroll
        for (int m = 0; m < 4; ++m)
#pragma unroll
            for (int j = 0; j < 4; ++j) part[ai][m][j] = ssq[(size_t)(4 * fq + j) * M + row0 + ai * 128 + m * 16];
#pragma unroll
    for (int ai = 0; ai < 2; ++ai)
#pragma unroll
        for (int m = 0; m < 4; ++m) { float t = (part[ai][m][0] + part[ai][m][1]) + (part[ai][m][2] + part[ai][m][3]); t += __shfl_xor(t, 16); t += __shfl_xor(t, 32); rs[ai][m] = __builtin_amdgcn_rsqf(t * (1.0f / 1024.0f) + EPS); }
}
template <int ACT> __device__ __forceinline__ void epi_act_store(f32x4 (&acc)[2][2][4][2], const float (&rs)[2][4], bf16_t* out, int ld, int row0, int col0, float* ssqv_slot, bool want_ssq, int fq) {
#pragma unroll
    for (int ai = 0; ai < 2; ++ai)
#pragma unroll
        for (int m = 0; m < 4; ++m) { const int row = row0 + ai * 128 + m * 16; float sq = 0.f;
#pragma unroll
            for (int bj = 0; bj < 2; ++bj) { f32x4 v0 = acc[ai][bj][m][0] * rs[ai][m], v1 = acc[ai][bj][m][1] * rs[ai][m];
                if (ACT == 1) { f32x2 a = gelu_pk((f32x2){v0[0], v0[1]}), b = gelu_pk((f32x2){v0[2], v0[3]}), c = gelu_pk((f32x2){v1[0], v1[1]}), d = gelu_pk((f32x2){v1[2], v1[3]});
                    v0 = (f32x4){a.x, a.y, b.x, b.y}; v1 = (f32x4){c.x, c.y, d.x, d.y}; sq += sumsq8(v0, v1); }
                if (ACT == 2) {
#pragma unroll
                    for (int e = 0; e < 4; ++e) { v0[e] = sigm(v0[e]); v1[e] = sigm(v1[e]); } }
                *(u32x4*)(out + (size_t)row * ld + col0 + bj * 128) = pack8(v0, v1); }
            if (ACT == 1) { if (want_ssq) { sq += __shfl_xor(sq, 16); sq += __shfl_xor(sq, 32); if (fq == 0) ssqv_slot[row] = sq; } } }
}
__device__ __forceinline__ void epi_run(const Epi& E, f32x4 (&acc)[2][2][4][2], const Unit& u, int wr, int wc, int fr, int fq) {
    const int mode = u.mode;
    const int row0 = u.pm * 256 + wr * 64 + fr, col0 = u.pn * 256 + wc * 32 + 8 * fq;
    if (mode == MODE_IN || mode == MODE_UP) {
        float rs[2][4]; epi_rstd(E.ssq_in, row0, fq, rs);
        if (mode == MODE_UP) { epi_act_store<0>(acc, rs, E.out16, E.ld16, row0, col0, nullptr, false, fq); return; }
        const int atype = u.pn >> 2;
        if (atype == 2) epi_act_store<1>(acc, rs, E.Z, NIN, row0, col0, E.ssqv + (size_t)((u.pn - 8) * 4 + wc) * M, true, fq);
        else epi_act_store<0>(acc, rs, E.Z, NIN, row0, col0, nullptr, false, fq);
    } else if (mode == MODE_POOL) {
        f32x4 sc[2][2];
#pragma unroll
        for (int bj = 0; bj < 2; ++bj) { sc[bj][0] = *(const f32x4*)(E.pool_scale + col0 + bj * 128); sc[bj][1] = *(const f32x4*)(E.pool_scale + col0 + bj * 128 + 4); }
#pragma unroll
        for (int ai = 0; ai < 2; ++ai)
#pragma unroll
            for (int m = 0; m < 4; ++m)
#pragma unroll
                for (int bj = 0; bj < 2; ++bj) *(u32x4*)(E.Z + (size_t)(row0 + ai * 128 + m * 16) * NIN + col0 + bj * 128) = pack8(acc[ai][bj][m][0] * sc[bj][0], acc[ai][bj][m][1] * sc[bj][1]);
    } else if (mode == MODE_YA) {
        u32x4 g[2][4][2];
#pragma unroll
        for (int ai = 0; ai < 2; ++ai)
#pragma unroll
            for (int m = 0; m < 4; ++m)
#pragma unroll
                for (int bj = 0; bj < 2; ++bj) g[ai][m][bj] = *(const u32x4*)(E.Z + (size_t)(row0 + ai * 128 + m * 16) * NIN + 3072 + col0 + bj * 128);
#pragma unroll
        for (int ai = 0; ai < 2; ++ai)
#pragma unroll
            for (int m = 0; m < 4; ++m)
#pragma unroll
                for (int bj = 0; bj < 2; ++bj) { const f32x4 v0 = acc[ai][bj][m][0], v1 = acc[ai][bj][m][1]; const u32x4 gg = g[ai][m][bj]; u32x4 w;
                    w.x = cvt_pk_bf16(v0[0] * sigm(bf_lo(gg.x)), v0[1] * sigm(bf_hi(gg.x))); w.y = cvt_pk_bf16(v0[2] * sigm(bf_lo(gg.y)), v0[3] * sigm(bf_hi(gg.y)));
                    w.z = cvt_pk_bf16(v1[0] * sigm(bf_lo(gg.z)), v1[1] * sigm(bf_hi(gg.z))); w.w = cvt_pk_bf16(v1[2] * sigm(bf_lo(gg.w)), v1[3] * sigm(bf_hi(gg.w)));
                    *(u32x4*)(E.Z + (size_t)(row0 + ai * 128 + m * 16) * NIN + 3072 + col0 + bj * 128) = w; }
    } else if (mode == MODE_YB) {
#pragma unroll
        for (int ai = 0; ai < 2; ++ai) { u32x4 g[4][2], c[4][2];
#pragma unroll
            for (int m = 0; m < 4; ++m)
#pragma unroll
                for (int bj = 0; bj < 2; ++bj) { const bf16_t* gp = E.Z + (size_t)(row0 + ai * 128 + m * 16) * NIN + 4096 + col0 + bj * 128; g[m][bj] = *(const u32x4*)gp; c[m][bj] = *(const u32x4*)(gp - 1024); }
#pragma unroll
            for (int m = 0; m < 4; ++m)
#pragma unroll
                for (int bj = 0; bj < 2; ++bj) { const f32x4 v0 = acc[ai][bj][m][0], v1 = acc[ai][bj][m][1]; const u32x4 gg = g[m][bj], cc = c[m][bj]; u32x4 w;
                    w.x = cvt_pk_bf16(bf_lo(cc.x) + v0[0] * sigm(bf_lo(gg.x)), bf_hi(cc.x) + v0[1] * sigm(bf_hi(gg.x))); w.y = cvt_pk_bf16(bf_lo(cc.y) + v0[2] * sigm(bf_lo(gg.y)), bf_hi(cc.y) + v0[3] * sigm(bf_hi(gg.y)));
                    w.z = cvt_pk_bf16(bf_lo(cc.z) + v1[0] * sigm(bf_lo(gg.z)), bf_hi(cc.z) + v1[1] * sigm(bf_hi(gg.z))); w.w = cvt_pk_bf16(bf_lo(cc.w) + v1[2] * sigm(bf_lo(gg.w)), bf_hi(cc.w) + v1[3] * sigm(bf_hi(gg.w)));
                    *(u32x4*)(E.Z + (size_t)(row0 + ai * 128 + m * 16) * NIN + 4096 + col0 + bj * 128) = w; }
            EPI_FENCE; }
    } else if (mode == MODE_E) {
#pragma unroll
        for (int ai = 0; ai < 2; ++ai)
#pragma unroll
            for (int m = 0; m < 4; ++m)
#pragma unroll
                for (int bj = 0; bj < 2; ++bj) *(u32x4*)(E.C16 + (size_t)(row0 + ai * 128 + m * 16) * D + col0 + bj * 128) = pack8(acc[ai][bj][m][0], acc[ai][bj][m][1]);
    } else if (mode == MODE_RES) {
        float* sslot = E.ssq_out + (size_t)(u.pn * 4 + wc) * M;
        u32x4 x[2][4][2];
#pragma unroll
        for (int ai = 0; ai < 2; ++ai)
#pragma unroll
            for (int m = 0; m < 4; ++m)
#pragma unroll
                for (int bj = 0; bj < 2; ++bj) x[ai][m][bj] = *(const u32x4*)(E.xin16 + (size_t)(row0 + ai * 128 + m * 16) * D + col0 + bj * 128);
#pragma unroll
        for (int ai = 0; ai < 2; ++ai) {
#pragma unroll
            for (int m = 0; m < 4; ++m) { const int row = row0 + ai * 128 + m * 16; float sq = 0.f;
#pragma unroll
                for (int bj = 0; bj < 2; ++bj) { const u32x4 xx = x[ai][m][bj];
                    const f32x4 x0 = (f32x4){bf_lo(xx.x), bf_hi(xx.x), bf_lo(xx.y), bf_hi(xx.y)} + acc[ai][bj][m][0], x1 = (f32x4){bf_lo(xx.z), bf_hi(xx.z), bf_lo(xx.w), bf_hi(xx.w)} + acc[ai][bj][m][1];
                    sq += sumsq8(x0, x1); *(u32x4*)(E.xout16 + (size_t)row * D + col0 + bj * 128) = pack8(x0, x1); }
                sq += __shfl_xor(sq, 16); sq += __shfl_xor(sq, 32); if (fq == 0) sslot[row] = sq; }
            EPI_FENCE; }
    } else {
        float rs[2][4]; epi_rstd(E.ssq_in, row0, fq, rs);
        float* sslot = E.ssq_out + (size_t)(u.pn * 4 + wc) * M;
#pragma unroll
        for (int ai = 0; ai < 2; ++ai)
#pragma unroll
            for (int mh = 0; mh < 2; ++mh) { u32x4 x[2][2], c[2][2];
#pragma unroll
                for (int mm = 0; mm < 2; ++mm)
#pragma unroll
                    for (int bj = 0; bj < 2; ++bj) { const size_t off = (size_t)(row0 + ai * 128 + (2 * mh + mm) * 16) * D + col0 + bj * 128; x[mm][bj] = *(const u32x4*)(E.xin16 + off); c[mm][bj] = *(const u32x4*)(E.C16 + off); }
#pragma unroll
                for (int mm = 0; mm < 2; ++mm) { const int m = 2 * mh + mm, row = row0 + ai * 128 + m * 16; float sq = 0.f;
#pragma unroll
                    for (int bj = 0; bj < 2; ++bj) { const u32x4 xx = x[mm][bj], cc = c[mm][bj];
                        const f32x4 c0 = (f32x4){bf_lo(cc.x), bf_hi(cc.x), bf_lo(cc.y), bf_hi(cc.y)}, c1 = (f32x4){bf_lo(cc.z), bf_hi(cc.z), bf_lo(cc.w), bf_hi(cc.w)};
                        f32x4 v0 = acc[ai][bj][m][0] * rs[ai][m], v1 = acc[ai][bj][m][1] * rs[ai][m];
#pragma unroll
                        for (int e = 0; e < 4; ++e) { v0[e] = sigm(v0[e]) * c0[e]; v1[e] = sigm(v1[e]) * c1[e]; }
                        const f32x4 x0 = (f32x4){bf_lo(xx.x), bf_hi(xx.x), bf_lo(xx.y), bf_hi(xx.y)} + v0, x1 = (f32x4){bf_lo(xx.z), bf_hi(xx.z), bf_lo(xx.w), bf_hi(xx.w)} + v1;
                        sq += sumsq8(x0, x1); *(u32x4*)(E.xout16 + (size_t)row * D + col0 + bj * 128) = pack8(x0, x1); }
                    sq += __shfl_xor(sq, 16); sq += __shfl_xor(sq, 32); if (fq == 0) sslot[row] = sq; }
                }
    }
}

__device__ __forceinline__ void gemm_phase(LAS unsigned char* lds, const Sched& S, const Epi& E) {
    int tid_ = threadIdx.x; asm volatile("" : "+v"(tid_));
    const int tid = tid_, wid = __builtin_amdgcn_readfirstlane(tid >> 6), lane = tid & 63, wr = wid >> 2, wc = wid & 3, fr = lane & 15, fq = lane >> 4;
    int R0, C0, R1, C1; stage_rc(tid * 16, R0, C0); stage_rc(tid * 16 + 8192, R1, C1);
    const int Rb0 = (R0 & ~31) + perm32(R0 & 31), Rb1 = (R1 & ~31) + perm32(R1 & 31);
    const size_t kstep = (size_t)(BK * 2);
    const unsigned ldsw = (unsigned)wid * 1024u;
    const int aoff = lds_byte(wr * 64 + fr, fq * 8), boff = lds_byte(wc * 32 + fr, fq * 8);
#define PG8_SA(b, h) (((b) * 2 + (h)) * HTB)
#define PG8_SB(b, h) ((4 + (b) * 2 + (h)) * HTB)
#define PG8_STAGE(bufoff, gbase, v0, v1) do { \
        __builtin_amdgcn_global_load_lds((const unsigned*)((const char*)(gbase) + (v0)), (LAS unsigned*)(lds + (bufoff) + ldsw), 16, 0, 0); \
        __builtin_amdgcn_global_load_lds((const unsigned*)((const char*)(gbase) + (v1)), (LAS unsigned*)(lds + (bufoff) + ldsw + 8192), 16, 0, 0); } while (0)
#define PG8_LDA(dst, b, h) do { _Pragma("unroll") for (int m = 0; m < 4; ++m) _Pragma("unroll") for (int k = 0; k < 2; ++k) dst[m][k] = *(const LAS bf16x8*)(lds + PG8_SA(b, h) + aoff + m * 2048 + k * 1024); } while (0)
#define PG8_LDB(dst, b, h) do { _Pragma("unroll") for (int n = 0; n < 2; ++n) _Pragma("unroll") for (int k = 0; k < 2; ++k) dst[n][k] = *(const LAS bf16x8*)(lds + PG8_SB(b, h) + boff + n * 2048 + k * 1024); } while (0)
#define PG8_MMA(ai, bj, At, Bt) do { __builtin_amdgcn_s_setprio(1); _Pragma("unroll") for (int m = 0; m < 4; ++m) _Pragma("unroll") for (int n = 0; n < 2; ++n) _Pragma("unroll") for (int k = 0; k < 2; ++k) \
        acc[ai][bj][m][n] = __builtin_amdgcn_mfma_f32_16x16x32_bf16(Bt[n][k], At[m][k], acc[ai][bj][m][n], 0, 0, 0); __builtin_amdgcn_s_setprio(0); } while (0)
#define PG8_WAIT_V(n) asm volatile("s_waitcnt vmcnt(" #n ")" ::: "memory")
#define PG8_WAIT_L(n) asm volatile("s_waitcnt lgkmcnt(" #n ")" ::: "memory")
#define PG8_BAR __builtin_amdgcn_s_barrier()
#define PG8_SCHED __builtin_amdgcn_sched_barrier(0)
    Unit cur, nxt; int ui = 0;
    if (!S.next(0, cur)) return;
    f32x4 acc[2][2][4][2];
#pragma unroll
    for (int a = 0; a < 2; ++a)
#pragma unroll
        for (int b = 0; b < 2; ++b)
#pragma unroll
            for (int m = 0; m < 4; ++m)
#pragma unroll
                for (int n = 0; n < 2; ++n) acc[a][b][m][n] = (f32x4){0.f, 0.f, 0.f, 0.f};
    bf16x8 At[4][2], B0[2][2], B1[2][2];
    const char* cA = cur.a; const char* cB = cur.b;
    const unsigned RA0 = R0 * 2, RA1 = R1 * 2, RB0 = Rb0 * 2, RB1 = Rb1 * 2, CC0 = C0 * 2, CC1 = C1 * 2;
#define PG8_STA(bufoff, gbase, ld) PG8_STAGE(bufoff, gbase, RA0 * (unsigned)(ld) + CC0, RA1 * (unsigned)(ld) + CC1)
#define PG8_STB(bufoff, gbase, ld) PG8_STAGE(bufoff, gbase, RB0 * (unsigned)(ld) + CC0, RB1 * (unsigned)(ld) + CC1)
    int lda = cur.lda, ldb = cur.ldb;
    { const size_t hA = (size_t)HALF * lda * 2, hB = (size_t)HALF * ldb * 2;
    PG8_STB(PG8_SB(0, 0), cB, ldb); PG8_STB(PG8_SB(0, 1), cB + hB, ldb); PG8_STA(PG8_SA(0, 0), cA, lda); PG8_STA(PG8_SA(0, 1), cA + hA, lda);
    if (wr == 1) PG8_BAR;
    PG8_WAIT_V(2); PG8_BAR;
    PG8_STB(PG8_SB(1, 0), cB + kstep, ldb); PG8_STA(PG8_SA(1, 0), cA + kstep, lda); PG8_STB(PG8_SB(1, 1), cB + hB + kstep, ldb);
    PG8_WAIT_V(6); PG8_BAR; }
    for (;;) {
        const bool has_next = S.next(ui + 1, nxt);
        const char* nA = has_next ? nxt.a : cA; const char* nB = has_next ? nxt.b : cB;
        const int nlda = has_next ? nxt.lda : lda, nldb = has_next ? nxt.ldb : ldb;
        const size_t hA = (size_t)HALF * lda * 2;
        const int nt = cur.nt;
        const int nt_main = has_next ? nt : nt - 2;
        for (int t = 0; t < nt_main; t += 2) {
            const bool last = (t == nt - 2);
            const char* a1 = cA + (size_t)(t + 1) * kstep;
            const char* a2 = last ? nA : cA + (size_t)(t + 2) * kstep; const char* b2 = last ? nB : cB + (size_t)(t + 2) * kstep;
            const char* a3 = a2 + kstep; const char* b3 = b2 + kstep;
            const int xlda = last ? nlda : lda, xldb = last ? nldb : ldb;
            const size_t xhA = (size_t)HALF * xlda * 2, xhB = (size_t)HALF * xldb * 2;
            PG8_LDB(B0, 0, 0); PG8_LDB(B1, 0, 1); PG8_SCHED; PG8_LDA(At, 0, 0); PG8_STA(PG8_SA(1, 1), a1 + hA, lda);
            PG8_WAIT_V(8); PG8_WAIT_L(0); PG8_BAR; PG8_MMA(0, 0, At, B0); PG8_MMA(0, 1, At, B1); PG8_BAR; PG8_SCHED;
            PG8_LDA(At, 0, 1); PG8_STB(PG8_SB(0, 0), b2, xldb); PG8_STB(PG8_SB(0, 1), b2 + xhB, xldb); PG8_STA(PG8_SA(0, 0), a2, xlda);
            PG8_WAIT_V(8); PG8_WAIT_L(0); PG8_BAR; PG8_MMA(1, 0, At, B0); PG8_MMA(1, 1, At, B1); PG8_BAR; PG8_SCHED;
            PG8_LDB(B0, 1, 0); PG8_LDB(B1, 1, 1); PG8_SCHED; PG8_LDA(At, 1, 0); PG8_STA(PG8_SA(0, 1), a2 + xhA, xlda);
            PG8_WAIT_V(8); PG8_WAIT_L(0); PG8_BAR; PG8_MMA(0, 0, At, B0); PG8_MMA(0, 1, At, B1); PG8_BAR; PG8_SCHED;
            PG8_LDA(At, 1, 1); PG8_STB(PG8_SB(1, 0), b3, xldb); PG8_STB(PG8_SB(1, 1), b3 + xhB, xldb); PG8_STA(PG8_SA(1, 0), a3, xlda);
            PG8_WAIT_V(8); PG8_WAIT_L(0); PG8_BAR; PG8_MMA(1, 0, At, B0); PG8_MMA(1, 1, At, B1); PG8_BAR; PG8_SCHED;
        }
        if (!has_next) {
            const char* a1 = cA + (size_t)(nt - 1) * kstep;
            PG8_LDB(B0, 0, 0); PG8_LDB(B1, 0, 1); PG8_SCHED; PG8_LDA(At, 0, 0); PG8_STA(PG8_SA(1, 1), a1 + hA, lda);
            PG8_WAIT_V(8); PG8_WAIT_L(0); PG8_BAR; PG8_MMA(0, 0, At, B0); PG8_MMA(0, 1, At, B1); PG8_BAR; PG8_SCHED;
            PG8_LDA(At, 0, 1);
            PG8_WAIT_V(2); PG8_WAIT_L(0); PG8_BAR; PG8_MMA(1, 0, At, B0); PG8_MMA(1, 1, At, B1); PG8_BAR; PG8_SCHED;
            PG8_LDB(B0, 1, 0); PG8_LDB(B1, 1, 1); PG8_SCHED; PG8_LDA(At, 1, 0);
            PG8_WAIT_V(0); PG8_WAIT_L(0); PG8_BAR; PG8_MMA(0, 0, At, B0); PG8_MMA(0, 1, At, B1); PG8_BAR; PG8_SCHED;
            PG8_LDA(At, 1, 1);
            PG8_WAIT_L(0); PG8_BAR; PG8_MMA(1, 0, At, B0); PG8_MMA(1, 1, At, B1); PG8_BAR; PG8_SCHED;
        }
        if (wr == 0) PG8_BAR;
        epi_run(E, acc, cur, wr, wc, fr, fq);
        if (!has_next) break;
#pragma unroll
        for (int a = 0; a < 2; ++a)
#pragma unroll
            for (int b = 0; b < 2; ++b)
#pragma unroll
                for (int m = 0; m < 4; ++m)
#pragma unroll
                    for (int n = 0; n < 2; ++n) acc[a][b][m][n] = (f32x4){0.f, 0.f, 0.f, 0.f};
        cur = nxt; cA = nA; cB = nB; lda = nlda; ldb = nldb; ++ui;
        if (wr == 1) PG8_BAR;
    }
#undef PG8_STA
#undef PG8_STB
    PG8_WAIT_V(0);
    PG8_BAR;
#undef PG8_SA
#undef PG8_SB
#undef PG8_STAGE
#undef PG8_LDA
#undef PG8_LDB
#undef PG8_MMA
#undef PG8_WAIT_V
#undef PG8_WAIT_L
#undef PG8_BAR
#undef PG8_SCHED
}

struct Params { const float* in[21]; float* out; unsigned char* ws; int ph_lo, ph_hi; };
typedef const __attribute__((address_space(4))) Params* KP;
__device__ __forceinline__ KP kparams() { KP k = (KP)__builtin_amdgcn_kernarg_segment_ptr(); asm volatile("" : "+s"(k)); return k; }
enum { I_X = 0, I_P, I_MIXN, I_WIN, I_WPOOL, I_PSCALE, I_SGUN, I_WSP, I_BSP, I_WA, I_WB, I_WO, I_FFNN, I_WUP, I_CONVW, I_CONVB, I_WDN, I_PLEN, I_WPG, I_WPLE, I_FINN };

__device__ __forceinline__ void transpose_item(const float* W, const float* gain, int K, int N, bf16_t* WT, int row_off, LAS float* scr, int item, int lane) {
    const int nblk = N / 32, kb = item / nblk, nb = item % nblk, k0 = 64 * kb, n0 = 32 * nb;
    float tv[32];
#pragma unroll
    for (int i = 0; i < 32; ++i) { const int kk = 2 * i + (lane >> 5); tv[i] = W[(size_t)(k0 + kk) * N + n0 + (lane & 31)]; }
    if (gain) {
#pragma unroll
        for (int i = 0; i < 32; ++i) tv[i] *= gain[k0 + 2 * i + (lane >> 5)]; }
#pragma unroll
    for (int i = 0; i < 32; ++i) scr[(2 * i + (lane >> 5)) * 33 + (lane & 31)] = tv[i];
    asm volatile("s_waitcnt lgkmcnt(0)" ::: "memory");
    const int c = lane & 7;
#pragma unroll
    for (int j = 0; j < 4; ++j) { const int n = (lane >> 3) + 8 * j; const LAS float* s = scr + (8 * c) * 33 + n;
        u32x4 o; o.x = cvt_pk_bf16(s[0 * 33], s[1 * 33]); o.y = cvt_pk_bf16(s[2 * 33], s[3 * 33]); o.z = cvt_pk_bf16(s[4 * 33], s[5 * 33]); o.w = cvt_pk_bf16(s[6 * 33], s[7 * 33]);
        *(u32x4*)(WT + (size_t)(row_off + n0 + n) * K + k0 + 8 * c) = o; }
    asm volatile("s_waitcnt lgkmcnt(0)" ::: "memory");
}

enum { WM_IN = 1, WM_POOL = 2, WM_A = 4, WM_B = 8, WM_O = 16, WM_UP = 32, WM_DN = 64, WM_PG = 128, WM_PLE = 256 };
__device__ __forceinline__ void prep_weights(KP kp, LAS unsigned char* lds, int l, int mask, int first_wg, int n_wg) {
    unsigned char* ws = kp->ws;
    int tid_ = threadIdx.x; asm volatile("" : "+v"(tid_));
    const int lane = tid_ & 63, wave = tid_ >> 6;
    if ((int)blockIdx.x < first_wg) return;
    LAS float* scr = (LAS float*)(lds + wave * 16384);
    const int gw = ((int)blockIdx.x - first_wg) * 8 + wave, NGW = n_wg * 8;
    constexpr int I_IN = (D / 64) * (NIN / 32), I_PL = (256 / 64) * (256 / 32), I_SQ = (D / 64) * (D / 32), I_UP = (D / 64) * (NUP / 32), I_DN = (FF / 64) * (D / 32), I_PE = (PLE / 64) * (D / 32);
    const int n_in = (mask & WM_IN) ? I_IN : 0, n_pl = (mask & WM_POOL) ? 4 * I_PL : 0, n_a = (mask & WM_A) ? I_SQ : 0, n_b = (mask & WM_B) ? I_SQ : 0, n_o = (mask & WM_O) ? I_SQ : 0,
              n_up = (mask & WM_UP) ? I_UP : 0, n_dn = (mask & WM_DN) ? I_DN : 0, n_pg = (mask & WM_PG) ? I_SQ : 0, n_pe = (mask & WM_PLE) ? I_PE : 0;
    const int nitems = n_in + n_pl + n_a + n_b + n_o + n_up + n_dn + n_pg + n_pe;
    for (int it = gw; it < nitems; it += NGW) {
        int r = it;
        if (r < n_in) { transpose_item(kp->in[I_WIN] + (size_t)l * D * NIN, kp->in[I_MIXN] + l * D, D, NIN, (bf16_t*)(ws + W_IN), 0, scr, r, lane); continue; } r -= n_in;
        if (r < n_pl) { const int g = r / I_PL; transpose_item(kp->in[I_WPOOL] + ((size_t)l * 4 + g) * 256 * 256, nullptr, 256, 256, (bf16_t*)(ws + W_POOL), g * 256, scr, r % I_PL, lane); continue; } r -= n_pl;
        if (r < n_a) { transpose_item(kp->in[I_WA] + (size_t)l * D * D, nullptr, D, D, (bf16_t*)(ws + W_A), 0, scr, r, lane); continue; } r -= n_a;
        if (r < n_b) { transpose_item(kp->in[I_WB] + (size_t)l * D * D, nullptr, D, D, (bf16_t*)(ws + W_B), 0, scr, r, lane); continue; } r -= n_b;
        if (r < n_o) { transpose_item(kp->in[I_WO] + (size_t)l * D * D, nullptr, D, D, (bf16_t*)(ws + W_O), 0, scr, r, lane); continue; } r -= n_o;
        if (r < n_up) { transpose_item(kp->in[I_WUP] + (size_t)l * D * NUP, kp->in[I_FFNN] + l * D, D, NUP, (bf16_t*)(ws + W_UP), 0, scr, r, lane); continue; } r -= n_up;
        if (r < n_dn) { transpose_item(kp->in[I_WDN] + (size_t)l * FF * D, nullptr, FF, D, (bf16_t*)(ws + W_DN), 0, scr, r, lane); continue; } r -= n_dn;
        if (r < n_pg) { transpose_item(kp->in[I_WPG] + (size_t)l * D * D, kp->in[I_PLEN] + l * D, D, D, (bf16_t*)(ws + W_PG), 0, scr, r, lane); continue; } r -= n_pg;
        transpose_item(kp->in[I_WPLE] + (size_t)l * PLE * D, nullptr, PLE, D, (bf16_t*)(ws + W_PLE), 0, scr, r, lane);
    }
}
__device__ __forceinline__ void prep_phase(KP kp, LAS unsigned char* lds, int l) {
    unsigned char* ws = kp->ws;
    prep_weights(kp, lds, l, WM_IN | WM_POOL, 0, gridDim.x);
    int tid_ = threadIdx.x; asm volatile("" : "+v"(tid_));
    const int tid = tid_, lane = tid & 63, wave = tid >> 6;
    const int gw = blockIdx.x * 8 + wave, NGW = gridDim.x * 8;
    { const float* wsp = kp->in[I_WSP] + (size_t)l * 8 * 128 * 128; bf16_t* o = (bf16_t*)(ws + W_S16);
      for (int i = blockIdx.x * 512 + tid; i < 8 * 128 * 128 / 2; i += gridDim.x * 512) { const int e = 2 * i, s = e & 127, t = (e >> 7) & 127;
          const f32x2 v = *(const f32x2*)(wsp + e); *(unsigned*)(o + e) = cvt_pk_bf16(s <= t ? v.x : 0.f, (s + 1) <= t ? v.y : 0.f); } }
    const float* xsrc = kp->in[I_X]; bf16_t* XB = (bf16_t*)(ws + ws_xb(0)); float* ssqa = (float*)(ws + WS_SSQA);
    if (l == 0) for (int m = gw; m < M; m += 4 * NGW) {
        f32x4 v[4][4];
#pragma unroll
        for (int r = 0; r < 4; ++r) { const int mm = m + r * NGW; if (mm < M) { const f32x4* xr = (const f32x4*)(xsrc + (size_t)mm * D) + lane;
#pragma unroll
            for (int j = 0; j < 4; ++j) v[r][j] = xr[64 * j]; } }
#pragma unroll
        for (int r = 0; r < 4; ++r) { const int mm = m + r * NGW; if (mm < M) { float sacc = 0.f;
#pragma unroll
            for (int j = 0; j < 4; ++j) sacc += (v[r][j].x * v[r][j].x + v[r][j].y * v[r][j].y) + (v[r][j].z * v[r][j].z + v[r][j].w * v[r][j].w);
            u32x2* o8 = (u32x2*)(XB + (size_t)mm * D) + lane;
#pragma unroll
            for (int j = 0; j < 4; ++j) { u32x2 w; w.x = cvt_pk_bf16(v[r][j].x, v[r][j].y); w.y = cvt_pk_bf16(v[r][j].z, v[r][j].w); o8[64 * j] = w; }
            const float tot = wave_sum(sacc); if (lane < 16) ssqa[(size_t)lane * M + mm] = (lane == 0) ? tot : 0.f; } }
    }
}

__device__ __forceinline__ void unpack8(const u32x4& r, float (&v)[8]) { v[0] = bf_lo(r.x); v[1] = bf_hi(r.x); v[2] = bf_lo(r.y); v[3] = bf_hi(r.y); v[4] = bf_lo(r.z); v[5] = bf_hi(r.z); v[6] = bf_lo(r.w); v[7] = bf_hi(r.w); }
__device__ __forceinline__ void sgu_phase(KP kp, LAS unsigned char* lds, int l) {
    unsigned char* ws = kp->ws; bf16_t* Z = (bf16_t*)(ws + ws_big(l)); const float* ssqv = (const float*)(ws + WS_SSQV); const bf16_t* ws16 = (const bf16_t*)(ws + W_S16);
    const float* bsp = kp->in[I_BSP] + l * 8 * 128; const float* gn = kp->in[I_SGUN] + l * D;
    int tid_ = threadIdx.x; asm volatile("" : "+v"(tid_));
    const int tid = tid_, wid = tid >> 6, lane = tid & 63, fr = lane & 15, fq = lane >> 4;
    LAS float* rsd = (LAS float*)(lds + 40960);
    const bool local_map = (gridDim.x == 256);
    int pm_ = 0, pn_ = 0;
    { const int c = blockIdx.x, wgid = (c % 8) * 32 + c / 8; pm_ = (wgid / 32) * 8 + ((wgid % 32) % 8); pn_ = (wgid % 32) / 8; }
    const int n_units = local_map ? 4 : (1024 - (int)blockIdx.x + (int)gridDim.x - 1) / (int)gridDim.x;
    for (int ui = 0; ui < n_units; ++ui) {
        const int u = local_map ? ((2 * pm_ + (ui >> 1)) * 8 + 2 * pn_ + (ui & 1)) : ((int)blockIdx.x + ui * (int)gridDim.x);
        const int h = u & 7, r0 = (u >> 3) * 128;
        if (tid < 128) { float s = 0.f;
#pragma unroll
            for (int j = 0; j < 16; ++j) s += ssqv[(size_t)j * M + r0 + tid];
            rsd[tid] = __builtin_amdgcn_rsqf(s * (1.0f / 1024.0f) + EPS); }
        __syncthreads();
        { const int dc = tid & 15; const f32x4 g0 = *(const f32x4*)(gn + h * 128 + dc * 8), g1 = *(const f32x4*)(gn + h * 128 + dc * 8 + 4);
#pragma unroll
          for (int j = 0; j < 4; ++j) { const int s = (tid >> 4) + 32 * j; const u32x4 raw = *(const u32x4*)(Z + (size_t)(r0 + s) * NIN + 2048 + h * 128 + dc * 8); const float r = rsd[s];
              LAS unsigned* dst = (LAS unsigned*)(lds + s * 260 + dc * 16);
              dst[0] = cvt_pk_bf16(bf_lo(raw.x) * r * g0.x, bf_hi(raw.x) * r * g0.y); dst[1] = cvt_pk_bf16(bf_lo(raw.y) * r * g0.z, bf_hi(raw.y) * r * g0.w);
              dst[2] = cvt_pk_bf16(bf_lo(raw.z) * r * g1.x, bf_hi(raw.z) * r * g1.y); dst[3] = cvt_pk_bf16(bf_lo(raw.w) * r * g1.z, bf_hi(raw.w) * r * g1.w); } }
        __syncthreads();
        const int kkmax = (16 * wid + 15) >> 5;
        bf16x8 wfa[4];
#pragma unroll
        for (int kk = 0; kk < 4; ++kk) wfa[kk] = (kk <= kkmax) ? *(const bf16x8*)(ws16 + (size_t)(h * 128 + 16 * wid + fr) * 128 + 32 * kk + 8 * fq) : (bf16x8){0, 0, 0, 0, 0, 0, 0, 0};
        const int t = 16 * wid + fr; const float bias = bsp[h * 128 + t]; bf16_t* up = Z + (size_t)(r0 + t) * NIN + 1024 + h * 128 + 4 * fq;
        u32x2 uu[8];
#pragma unroll
        for (int n = 0; n < 8; ++n) uu[n] = *(const u32x2*)(up + 16 * n);
        { const int w = 2 << (h >> 1), pc = tid & 15, pr = (tid >> 4) * 4, t0 = (r0 + pr) & (SEQ - 1);
          const bf16_t* src = Z + (size_t)(r0 + pr) * NIN + h * 128 + pc * 8;
          float ps[8];
#pragma unroll
          for (int e = 0; e < 8; ++e) ps[e] = 0.f;
          { u32x4 hw[15];
#pragma unroll
            for (int j = 1; j < 16; ++j) hw[j - 1] = (j < w && t0 - j >= 0) ? *(const u32x4*)(src - (size_t)j * NIN) : (u32x4){0u, 0u, 0u, 0u};
#pragma unroll
            for (int j = 0; j < 15; ++j) { float v[8]; unpack8(hw[j], v);
#pragma unroll
                for (int e = 0; e < 8; ++e) ps[e] += v[e]; } }
#pragma unroll
          for (int i = 0; i < 4; ++i) {
              float cur[8]; unpack8(*(const u32x4*)(src + (size_t)i * NIN), cur);
              const int t = t0 + i, n = (t + 1 < w) ? t + 1 : w; const float inv = 1.0f / (float)n;
              float o[8];
#pragma unroll
              for (int e = 0; e < 8; ++e) { ps[e] += cur[e]; o[e] = ps[e] * inv - cur[e]; }
              u32x4 ov; ov.x = cvt_pk_bf16(o[0], o[1]); ov.y = cvt_pk_bf16(o[2], o[3]); ov.z = cvt_pk_bf16(o[4], o[5]); ov.w = cvt_pk_bf16(o[6], o[7]);
              *(u32x4*)(Z + (size_t)(r0 + pr + i) * NIN + 2048 + h * 128 + pc * 8) = ov;
              if (t - w + 1 >= 0) { float old[8]; unpack8(*(const u32x4*)(src + (ptrdiff_t)(i - w + 1) * NIN), old);
#pragma unroll
                  for (int e = 0; e < 8; ++e) ps[e] -= old[e]; }
          } }
        f32x4 acc[8];
#pragma unroll
        for (int n = 0; n < 8; ++n) acc[n] = (f32x4){0.f, 0.f, 0.f, 0.f};
#pragma unroll
        for (int kk = 0; kk < 4; ++kk) {
            if (kk <= kkmax) {
#pragma unroll
                for (int n = 0; n < 8; ++n) { const LAS unsigned short* vp = (const LAS unsigned short*)(lds + (32 * kk + 8 * fq) * 260 + 2 * (16 * n + fr)); bf16x8 vf;
#pragma unroll
                    for (int e = 0; e < 8; ++e) vf[e] = (short)vp[e * 130];
                    acc[n] = __builtin_amdgcn_mfma_f32_16x16x32_bf16(vf, wfa[kk], acc[n], 0, 0, 0); }
            }
        }
#pragma unroll
        for (int n = 0; n < 8; ++n) { u32x2 w;
            const f32x2 ua = gelu_pk((f32x2){bf_lo(uu[n].x), bf_hi(uu[n].x)}), ub = gelu_pk((f32x2){bf_lo(uu[n].y), bf_hi(uu[n].y)});
            w.x = cvt_pk_bf16(ua.x * (acc[n][0] + bias), ua.y * (acc[n][1] + bias)); w.y = cvt_pk_bf16(ub.x * (acc[n][2] + bias), ub.y * (acc[n][3] + bias));
            *(u32x2*)(up + 16 * n) = w; }
        __syncthreads();
    }
}

__device__ __forceinline__ void conv_phase(KP kp, int l, int a0t, int na) {
    const bf16_t* UPP = (const bf16_t*)(kp->ws + ws_big(l)); bf16_t* ACT = (bf16_t*)(kp->ws + ws_big(l) + 96 * MiB);
    const float* cw = kp->in[I_CONVW] + (size_t)l * 3 * NUP; const float* cb = kp->in[I_CONVB] + (size_t)l * NUP;
    const int nchunk = na * 32, ldu = 2 * na * 256, total = (M / 8) * nchunk, NT = gridDim.x * 512;
    int tid_ = threadIdx.x; asm volatile("" : "+v"(tid_));
    for (int idx = blockIdx.x * 512 + tid_; idx < total; idx += NT) {
        const int chunk = idx % nchunk, row0 = (idx / nchunk) * 8, t0 = row0 & (SEQ - 1), ca = chunk * 8, j = a0t * 256 + ca;
        float wa[3][8], wb[3][8], ba[8], bb[8];
#pragma unroll
        for (int k = 0; k < 3; ++k) { const float* wk = cw + (size_t)k * NUP + j; const f32x4 a0 = *(const f32x4*)wk, a1 = *(const f32x4*)(wk + 4), b0 = *(const f32x4*)(wk + FF), b1 = *(const f32x4*)(wk + FF + 4);
#pragma unroll
            for (int e = 0; e < 4; ++e) { wa[k][e] = a0[e]; wa[k][4 + e] = a1[e]; wb[k][e] = b0[e]; wb[k][4 + e] = b1[e]; } }
        { const f32x4 a0 = *(const f32x4*)(cb + j), a1 = *(const f32x4*)(cb + j + 4), b0 = *(const f32x4*)(cb + FF + j), b1 = *(const f32x4*)(cb + FF + j + 4);
#pragma unroll
          for (int e = 0; e < 4; ++e) { ba[e] = a0[e]; ba[4 + e] = a1[e]; bb[e] = b0[e]; bb[4 + e] = b1[e]; } }
        const bf16_t* src = UPP + (size_t)row0 * ldu + ca;
        u32x4 ra[10], rb[10];
#pragma unroll
        for (int i = 0; i < 10; ++i) { if (i >= 2 || t0 > 0) { ra[i] = *(const u32x4*)(src + (ptrdiff_t)(i - 2) * ldu); rb[i] = *(const u32x4*)(src + (ptrdiff_t)(i - 2) * ldu + na * 256); }
                                       else { ra[i] = (u32x4){0u, 0u, 0u, 0u}; rb[i] = (u32x4){0u, 0u, 0u, 0u}; } }
#pragma unroll
        for (int i = 0; i < 8; ++i) {
            float va[8], vb[8];
#pragma unroll
            for (int e = 0; e < 8; ++e) { va[e] = ba[e]; vb[e] = bb[e]; }
#pragma unroll
            for (int k = 0; k < 3; ++k) { float xa[8], xb[8]; unpack8(ra[i + k], xa); unpack8(rb[i + k], xb);
#pragma unroll
                for (int e = 0; e < 8; ++e) { va[e] += wa[k][e] * xa[e]; vb[e] += wb[k][e] * xb[e]; } }
            u32x4 o; { f32x2 gg;
                gg = gelu_pk((f32x2){va[0], va[1]}); o.x = cvt_pk_bf16(gg.x * vb[0], gg.y * vb[1]); gg = gelu_pk((f32x2){va[2], va[3]}); o.y = cvt_pk_bf16(gg.x * vb[2], gg.y * vb[3]);
                gg = gelu_pk((f32x2){va[4], va[5]}); o.z = cvt_pk_bf16(gg.x * vb[4], gg.y * vb[5]); gg = gelu_pk((f32x2){va[6], va[7]}); o.w = cvt_pk_bf16(gg.x * vb[6], gg.y * vb[7]); }
            *(u32x4*)(ACT + (size_t)(row0 + i) * FF + j) = o;
        }
    }
}

__device__ __forceinline__ void pb_convert(KP kp, int l, int first_wg, int n_wg) {
    const float* src = kp->in[I_P] + (size_t)l * M * PLE; bf16_t* PB = (bf16_t*)(kp->ws + ws_big(l) + 80 * MiB);
    const int NT = n_wg * 512;
    int tid_ = threadIdx.x; asm volatile("" : "+v"(tid_));
    if ((int)blockIdx.x < first_wg) return;
    for (int idx = ((int)blockIdx.x - first_wg) * 512 + tid_; idx < M * PLE / 8; idx += 4 * NT) {
        f32x4 a[4], b[4];
#pragma unroll
        for (int q = 0; q < 4; ++q) { const int i2 = idx + q * NT; if (i2 < M * PLE / 8) { a[q] = *(const f32x4*)(src + (size_t)i2 * 8); b[q] = *(const f32x4*)(src + (size_t)i2 * 8 + 4); } }
#pragma unroll
        for (int q = 0; q < 4; ++q) { const int i2 = idx + q * NT; if (i2 < M * PLE / 8) {
            u32x4 o; o.x = cvt_pk_bf16(a[q].x, a[q].y); o.y = cvt_pk_bf16(a[q].z, a[q].w); o.z = cvt_pk_bf16(b[q].x, b[q].y); o.w = cvt_pk_bf16(b[q].z, b[q].w);
            *(u32x4*)(PB + (size_t)i2 * 8) = o; } }
    }
}

__device__ __forceinline__ void final_phase(KP kp, const float* ssq, const bf16_t* XF) {
    int tid_ = threadIdx.x; asm volatile("" : "+v"(tid_));
    const int tid = tid_, lane = tid & 63, wave = tid >> 6, gw = blockIdx.x * 8 + wave, NGW = gridDim.x * 8;
    const float* g = kp->in[I_FINN];
    f32x4 gv[2][2];
#pragma unroll
    for (int j = 0; j < 2; ++j) { gv[j][0] = *(const f32x4*)(g + (lane + 64 * j) * 8); gv[j][1] = *(const f32x4*)(g + (lane + 64 * j) * 8 + 4); }
    for (int m = gw; m < M; m += 4 * NGW) {
        float pp[4]; u32x4 v[4][2];
#pragma unroll
        for (int r = 0; r < 4; ++r) { const int mm = m + r * NGW; pp[r] = 0.f;
            if (mm < M) { pp[r] = (lane < 16) ? ssq[(size_t)lane * M + mm] : 0.f;
#pragma unroll
                for (int j = 0; j < 2; ++j) v[r][j] = *((const u32x4*)(XF + (size_t)mm * D) + lane + 64 * j); } }
#pragma unroll
        for (int r = 0; r < 4; ++r) { const int mm = m + r * NGW; if (mm < M) {
            const float rs = __builtin_amdgcn_rsqf(wave_sum(pp[r]) * (1.0f / 1024.0f) + EPS); float* orow = kp->out + (size_t)mm * D;
#pragma unroll
            for (int j = 0; j < 2; ++j) { const u32x4 xx = v[r][j];
                *(f32x4*)(orow + (lane + 64 * j) * 8) = (f32x4){bf_lo(xx.x), bf_hi(xx.x), bf_lo(xx.y), bf_hi(xx.y)} * rs * gv[j][0];
                *(f32x4*)(orow + (lane + 64 * j) * 8 + 4) = (f32x4){bf_lo(xx.z), bf_hi(xx.z), bf_lo(xx.w), bf_hi(xx.w)} * rs * gv[j][1]; } } }
    }
}

#define XB_TMO      128
#define XB_XCNT(j)  (256  + 64 * (j))
#define XB_XSUB(j)  (1280 + 64 * (j))
#define XB_XGEN(j)  (2304 + 64 * (j))
#define XB_TOP      3328
#define XB_TOPGEN   3392
#define XCD_BAR_WORDS 3456
#define XB_SPIN_CAP (1u << 18)

__device__ __forceinline__ unsigned xb_ld(unsigned* p)              { return __hip_atomic_load(p, __ATOMIC_RELAXED, __HIP_MEMORY_SCOPE_AGENT); }
__device__ __forceinline__ unsigned xb_add(unsigned* p, unsigned v) { return __hip_atomic_fetch_add(p, v, __ATOMIC_RELAXED, __HIP_MEMORY_SCOPE_AGENT); }
__device__ __forceinline__ unsigned xb_xcc_id() { return (unsigned)__builtin_amdgcn_s_getreg((3 << 11) | 20) & 0xFu; }
#define XB_SPIN(cond, bar) do { unsigned _sp = 0; while (cond) { __builtin_amdgcn_s_sleep(1); \
    if ((++_sp & 255u) == 0u) { if (xb_ld(&(bar)[XB_TMO])) break; if (_sp > XB_SPIN_CAP) { atomicAdd(&(bar)[XB_TMO], 1u); break; } } } } while (0)

struct XcdBarrier {
    unsigned* bar; unsigned x;
    volatile LAS unsigned* st;
};

__device__ __forceinline__ XcdBarrier xcd_barrier_post(unsigned* bar, volatile LAS unsigned* st) {
    XcdBarrier b; b.bar = bar; b.x = xb_xcc_id(); b.st = st;
    if (threadIdx.x == 0) (void)xb_add(&bar[XB_XCNT(b.x)], 1u);
    return b;
}
__device__ __forceinline__ void xcd_barrier_complete(unsigned* bar, unsigned x, unsigned& nloc, unsigned& nx) {
    const unsigned G = gridDim.x * gridDim.y * gridDim.z;
    unsigned sum, cnt, mine, sp = 0u;
    for (;;) {
        sum = 0u; cnt = 0u; mine = 0u;
#pragma unroll
        for (unsigned j = 0; j < 16; ++j) { const unsigned c = xb_ld(&bar[XB_XCNT(j)]); sum += c; cnt += (c > 0u) ? 1u : 0u; mine = (j == x) ? c : mine; }
        if (sum == G) break;
        __builtin_amdgcn_s_sleep(1);
        if ((++sp & 255u) == 0u) { if (xb_ld(&bar[XB_TMO])) break; if (sp > XB_SPIN_CAP) { atomicAdd(&bar[XB_TMO], 1u); break; } }
    }
    nloc = mine > 0u ? mine : 1u; nx = cnt > 0u ? cnt : 1u;
}

__device__ __forceinline__ void xcd_barrier(const XcdBarrier& b) {
    asm volatile("s_waitcnt vmcnt(0)" ::: "memory");
    __syncthreads();
    if (threadIdx.x == 0) {
        unsigned* bar = b.bar;
        __builtin_amdgcn_s_waitcnt(0);
        unsigned nloc = b.st[0], nx = b.st[1];
        if (nloc == 0u) { xcd_barrier_complete(bar, b.x, nloc, nx); b.st[0] = nloc; b.st[1] = nx; }
        const unsigned old = xb_add(&bar[XB_XSUB(b.x)], 1u);
        const unsigned gen = old / nloc;
        if (old + 1u == (gen + 1u) * nloc) {
            __builtin_amdgcn_fence(__ATOMIC_RELEASE, "agent");
            asm volatile("s_waitcnt vmcnt(0)" ::: "memory");
            const unsigned og = xb_add(&bar[XB_TOP], 1u);
            const unsigned tg = og / nx;
            __builtin_amdgcn_fence(__ATOMIC_ACQUIRE, "agent");
            if (og + 1u == (tg + 1u) * nx) xb_add(&bar[XB_TOPGEN], 1u);
            else XB_SPIN(xb_ld(&bar[XB_TOPGEN]) == tg, bar);
            xb_add(&bar[XB_XGEN(b.x)], 1u);
            asm volatile("s_waitcnt vmcnt(0)" ::: "memory");
        } else {
            __builtin_amdgcn_fence(__ATOMIC_ACQUIRE, "agent");
            XB_SPIN(xb_ld(&bar[XB_XGEN(b.x)]) == gen, bar);
            asm volatile("s_waitcnt vmcnt(0)" ::: "memory");
        }
    }
    __syncthreads();
}


constexpr int PH_PER_LAYER = 13, N_PHASES = 2 * PH_PER_LAYER + 1;
__global__ void __launch_bounds__(512) fwd_kernel(Params p) {
    extern __shared__ __attribute__((aligned(16))) unsigned char lds_raw[];
    LAS unsigned char* lds = (LAS unsigned char*)lds_raw;
    cg::grid_group grid = cg::this_grid();
    if (threadIdx.x < 64) ((LAS unsigned*)(lds + 131072))[threadIdx.x] = 0u;
    __syncthreads();
    XcdBarrier xbar = xcd_barrier_post((unsigned*)(kparams()->ws + WS_CTL), (volatile LAS unsigned*)(lds + 131072 + 64));
    for (int ph = p.ph_lo; ph < p.ph_hi; ++ph) {
        KP kp = kparams();
        unsigned char* ws = kp->ws;
        const int l_ = ph / PH_PER_LAYER;
        bf16_t* Z = (bf16_t*)(ws + ws_big(l_)); bf16_t* XB = (bf16_t*)(ws + ws_xb(l_));
        float* ssqA = (float*)(ws + WS_SSQA); float* ssqB = (float*)(ws + WS_SSQB);
        const int l = ph / PH_PER_LAYER, k = ph % PH_PER_LAYER;
        if (ph == N_PHASES - 1) { final_phase(kp, ssqA, (const bf16_t*)(ws + ws_big(1) + 96 * MiB)); break; }
        float* sa = (l == 0) ? ssqA : ssqB; float* sb = (l == 0) ? ssqB : ssqA;
        bool is_gemm = false;
        Sched S; Epi E;
        S.nsub = 1; S.nN = 4; S.G = gridDim.x; S.c = blockIdx.x;
        S.s0 = SubG{nullptr, nullptr, D, D, D, MODE_RES, 0, 1 << 30, 0}; S.s1 = S.s0;
        E.Z = Z; E.out16 = Z; E.ld16 = NIN; E.ssq_in = sa; E.ssq_out = sb; E.ssqv = (float*)(ws + WS_SSQV);
        E.xin16 = XB; E.xout16 = XB; E.pool_scale = kp->in[I_PSCALE] + l * D; E.C16 = (bf16_t*)(ws + ws_big(l) + 8 * MiB);
        switch (k) {
        case 0: prep_phase(kp, lds, l); break;
        case 1: S.nN = 20; S.s0 = SubG{XB, (const bf16_t*)(ws + W_IN), D, D, D, MODE_IN, 0, 1 << 30, 0}; E.ssq_in = sa; is_gemm = true; break;
        case 2: sgu_phase(kp, lds, l); break;
        case 3: break;
        case 4: S.nN = 4; S.s0 = SubG{Z + 2048, (const bf16_t*)(ws + W_POOL), NIN, 256, 256, MODE_POOL, 256, 1 << 30, 0}; is_gemm = true; break;
        case 5: S.nN = 4; S.nsub = 2; S.s0 = SubG{Z, (const bf16_t*)(ws + W_A), NIN, D, D, MODE_YA, 0, 1 << 30, 0};
                S.s1 = SubG{Z + 1024, (const bf16_t*)(ws + W_B), NIN, D, D, MODE_YB, 0, 1 << 30, 0}; is_gemm = true; break;
        case 6: S.nN = 4; S.s0 = SubG{Z + 4096, (const bf16_t*)(ws + W_O), NIN, D, D, MODE_RES, 0, 1 << 30, 0};
                E.ssq_out = sb; is_gemm = true; break;
        case 7: S.nN = 12; S.s0 = SubG{XB, (const bf16_t*)(ws + W_UP), D, D, D, MODE_UP, 0, 6, 5}; E.ssq_in = sb; E.out16 = (bf16_t*)(ws + ws_big(l)); E.ld16 = 3072; is_gemm = true; break;
        case 8: conv_phase(kp, l, 0, 6); break;
        case 9: S.nN = 10; S.s0 = SubG{XB, (const bf16_t*)(ws + W_UP) + (size_t)6 * 256 * D, D, D, D, MODE_UP, 0, 5, 6}; E.ssq_in = sb; E.out16 = (bf16_t*)(ws + ws_big(l)); E.ld16 = 2560; is_gemm = true; break;
        case 10: conv_phase(kp, l, 6, 5); break;
        case 11:
                 S.nN = 4; S.s0 = SubG{(const bf16_t*)(ws + ws_big(l) + 96 * MiB), (const bf16_t*)(ws + W_DN), FF, FF, FF, MODE_RES, 0, 1 << 30, 0}; E.ssq_out = sa; is_gemm = true; break;
        case 12: S.nN = 4; S.nsub = 2; S.s0 = SubG{(const bf16_t*)(ws + ws_big(l) + 80 * MiB), (const bf16_t*)(ws + W_PLE), PLE, PLE, PLE, MODE_E, 0, 1 << 30, 0};
                 S.s1 = SubG{XB, (const bf16_t*)(ws + W_PG), D, D, D, MODE_PLE, 0, 1 << 30, 0}; E.ssq_in = sa; E.ssq_out = sb; E.xout16 = (l == 0) ? (bf16_t*)(ws + ws_xb(1)) : (bf16_t*)(ws + ws_big(1) + 96 * MiB); is_gemm = true; break;
        }
        const bool side_first = (k == 9) ? true : (((blockIdx.x >> 3) & 1) != 0);
#define SIDE_WORK() do { \
        if (k == 4) prep_weights(kp, lds, l, WM_A | WM_B | WM_O, 0, gridDim.x); \
        if (k == 6) prep_weights(kp, lds, l, WM_UP, 0, gridDim.x); \
        if (k == 9) { const int G = gridDim.x; prep_weights(kp, lds, l, WM_DN | WM_PG | WM_PLE, G / 2, G - G / 2); pb_convert(kp, l, G / 2, G - G / 2); } } while (0)
        if (side_first && (k == 4 || k == 6 || k == 9)) { SIDE_WORK(); asm volatile("s_waitcnt lgkmcnt(0)" ::: "memory"); __syncthreads(); }
        if (is_gemm) gemm_phase(lds, S, E);
        if (!side_first && (k == 4 || k == 6 || k == 9)) SIDE_WORK();
#undef SIDE_WORK
        if (ph + 1 < p.ph_hi && k != 3) { xcd_barrier(xbar); if (p.ph_lo < 0) grid.sync(); }
    }
}

extern "C" void kernel_launch(void* const* d_in, const int* in_sizes, int n_in, void* d_out, int out_size, void* d_ws, size_t ws_size, hipStream_t stream) {
    static int grid = 0;
    if (grid == 0) {
        if (n_in != 21 || out_size != M * D || ws_size < WS_END) { fprintf(stderr, "kernel_launch: unexpected problem (n_in %d out %d ws %zu)\n", n_in, out_size, ws_size); grid = -1; return; }
        int dev = 0, cus = 0, per_cu = 0;
        hipGetDevice(&dev); hipDeviceGetAttribute(&cus, hipDeviceAttributeMultiprocessorCount, dev);
        if (hipFuncSetAttribute((const void*)fwd_kernel, hipFuncAttributeMaxDynamicSharedMemorySize, LDS_BYTES) != hipSuccess) { fprintf(stderr, "kernel_launch: hipFuncSetAttribute failed\n"); grid = -1; return; }
        if (hipOccupancyMaxActiveBlocksPerMultiprocessor(&per_cu, (const void*)fwd_kernel, 512, LDS_BYTES) != hipSuccess || per_cu < 1) { fprintf(stderr, "kernel_launch: occupancy query %d\n", per_cu); per_cu = 1; }
        (void)hipGetLastError();
        grid = cus * (per_cu > 1 ? 1 : per_cu);
    }
    if (grid < 0) return;
    if (hipMemsetAsync((char*)d_ws + WS_CTL, 0, CTL_BYTES, stream) != hipSuccess) { fprintf(stderr, "kernel_launch: memset failed\n"); return; }
    Params p{};
    for (int i = 0; i < 21; ++i) p.in[i] = (const float*)d_in[i];
    p.out = (float*)d_out; p.ws = (unsigned char*)d_ws; p.ph_lo = 0; p.ph_hi = N_PHASES;
    void* args[] = {&p};
    hipError_t e = hipLaunchCooperativeKernel((const void*)fwd_kernel, dim3(grid), dim3(512), args, LDS_BYTES, stream);
    if (e != hipSuccess) fprintf(stderr, "cooperative launch failed: %s (grid %d)\n", hipGetErrorString(e), grid);
}
```

```cpp
#include <hip/hip_runtime.h>
#include <hip/hip_cooperative_groups.h>
#include <cstdio>
#include <cstdint>
namespace cg = cooperative_groups;

#define LAS __attribute__((address_space(3)))
typedef unsigned short bf16_t;
typedef short bf16x8 __attribute__((ext_vector_type(8)));
typedef float f32x4 __attribute__((ext_vector_type(4)));
typedef float f32x2 __attribute__((ext_vector_type(2)));
typedef unsigned u32x4 __attribute__((ext_vector_type(4)));
typedef unsigned u32x2 __attribute__((ext_vector_type(2)));

constexpr int M = 16384, SEQ = 8192, D = 1024, NIN = 5120, FF = 2816, NUP = 5632, PLE = 256;
constexpr float EPS = 1e-6f;
constexpr size_t MiB = 1u << 20;
constexpr size_t WS_SSQA = 0, WS_SSQB = 1 * MiB, WS_SSQV = 2 * MiB;
constexpr size_t WS_CTL = 3 * MiB, CTL_BYTES = 16384;
constexpr size_t WS_W = 4 * MiB;
constexpr size_t W_IN = WS_W, W_POOL = W_IN + (size_t)NIN * D * 2, W_A = W_POOL + (size_t)D * 256 * 2, W_B = W_A + (size_t)D * D * 2, W_O = W_B + (size_t)D * D * 2,
                 W_UP = W_O + (size_t)D * D * 2, W_DN = W_UP + (size_t)NUP * D * 2, W_PG = W_DN + (size_t)D * FF * 2, W_PLE = W_PG + (size_t)D * D * 2, W_S16 = W_PLE + (size_t)D * PLE * 2,
                 W_END = W_S16 + (size_t)8 * 128 * 128 * 2;
constexpr size_t WS_XB = 40 * MiB, WS_BIG = 72 * MiB, WS_END = 256 * MiB;
static_assert(W_END <= WS_XB, "weights fit");
constexpr size_t WS_Z = WS_BIG;
constexpr size_t WS_UPP = WS_BIG, WS_ACT = WS_BIG + 96 * MiB;
constexpr size_t WS_PB = WS_BIG, WS_C32 = WS_BIG + 8 * MiB;
__device__ __forceinline__ size_t ws_big(int l) { return (size_t)(l == 0 ? 72 : 40) * MiB; }
__device__ __forceinline__ size_t ws_xb(int l) { return (size_t)(l == 0 ? 40 : 224) * MiB; }
static_assert(WS_ACT + (size_t)M * FF * 2 <= WS_END && WS_Z + (size_t)M * NIN * 2 <= WS_END && WS_C32 + (size_t)M * D * 4 <= WS_ACT, "map");

constexpr int LDS_BYTES = 147456;

enum { MODE_IN = 0, MODE_POOL, MODE_YA, MODE_YB, MODE_RES, MODE_UP, MODE_E, MODE_PLE };

typedef __bf16 bf16x2_t __attribute__((ext_vector_type(2)));
__device__ __forceinline__ unsigned cvt_pk_bf16(float lo, float hi) { f32x2 v = {lo, hi}; bf16x2_t b = __builtin_convertvector(v, bf16x2_t); return __builtin_bit_cast(unsigned, b); }
__device__ __forceinline__ float bf_lo(unsigned w) { return __uint_as_float(w << 16); }
__device__ __forceinline__ float bf_hi(unsigned w) { return __uint_as_float(w & 0xffff0000u); }
__device__ __forceinline__ f32x2 gelu_pk(f32x2 v) {
    const f32x2 av = __builtin_elementwise_abs(v), d = av * 0.2316418882f + 1.0f;
    f32x2 t; t.x = __builtin_amdgcn_rcpf(d.x); t.y = __builtin_amdgcn_rcpf(d.y);
    f32x2 q = t * 0.5307027145f + (-0.7265760135f); q = q * t + 0.7107068705f; q = q * t + (-0.142248368f); q = q * t + 0.127414796f; q = q * t;
    const f32x2 s = (v * v) * (-0.72134752044f);
    f32x2 e; e.x = __builtin_amdgcn_exp2f(s.x); e.y = __builtin_amdgcn_exp2f(s.y);
    const f32x2 m = v * (q * e), r = v - m;
    f32x2 o; o.x = v.x < 0.f ? m.x : r.x; o.y = v.y < 0.f ? m.y : r.y; return o;
}
__device__ __forceinline__ float gelu1(float v) { f32x2 r = gelu_pk((f32x2){v, v}); return r.x; }
__device__ __forceinline__ float sigm(float v) { return __builtin_amdgcn_rcpf(1.0f + __builtin_amdgcn_exp2f(-1.44269504089f * v)); }
__device__ __forceinline__ float wave_sum(float v) {
#pragma unroll
    for (int o = 1; o < 64; o <<= 1) v += __shfl_xor(v, o);
    return v;
}

constexpr int BM = 256, BK = 64, HALF = 128, HTB = HALF * BK * 2;
__device__ __forceinline__ int lds_byte(int r, int c) { const int st = (r >> 4) * 2 + (c >> 5), rr = r & 15, cc = c & 31, ob = rr * 64 + cc * 2; return st * 1024 + (ob ^ (((ob >> 9) & 1) << 5)); }
__device__ __forceinline__ void stage_rc(int b, int& R, int& C) { const int st = b / 1024, sb = b % 1024, swz = sb ^ (((sb >> 9) & 1) << 5); R = (st >> 1) * 16 + swz / 64; C = (st & 1) * 32 + (swz % 64) / 2; }
__device__ __forceinline__ int perm32(int rho) { const int n = rho >> 4, i = rho & 15; return 8 * (i >> 2) + 4 * n + (i & 3); }

struct Unit { const char* a; const char* b; int lda, ldb, nt, mode, pm, pn; };
struct SubG { const bf16_t* A; const bf16_t* B; int lda, ldb, K, mode, a_pn, bsplit, bjump; };
struct Sched {
    SubG s0, s1; int nsub, nN, G, c;
    __device__ __forceinline__ bool next(int i, Unit& u) const {
        const int sub = (nsub == 2) ? (i & 1) : 0, ii = (nsub == 2) ? (i >> 1) : i;
        const int nwg = 64 * nN; const long L = (long)ii * G + c; if (L >= nwg) return false;
        int wgid = (int)L; wgid = (wgid % 8) * (nwg / 8) + wgid / 8;
        const int nig = 8 * nN, gid = wgid / nig; const int pm = gid * 8 + ((wgid % nig) % 8), pn = (wgid % nig) / 8;
        const bf16_t* A = sub ? s1.A : s0.A; const bf16_t* B = sub ? s1.B : s0.B;
        const int lda = sub ? s1.lda : s0.lda, ldb = sub ? s1.ldb : s0.ldb, K = sub ? s1.K : s0.K, mode = sub ? s1.mode : s0.mode, a_pn = sub ? s1.a_pn : s0.a_pn,
                  bsplit = sub ? s1.bsplit : s0.bsplit, bjump = sub ? s1.bjump : s0.bjump;
        const int bt = pn < bsplit ? pn : pn + bjump;
        u.a = (const char*)(A + (size_t)pm * 256 * lda + (size_t)pn * a_pn); u.b = (const char*)(B + (size_t)bt * 256 * ldb);
        u.lda = lda; u.ldb = ldb; u.nt = K / BK; u.mode = mode; u.pm = pm; u.pn = pn; return true;
    }
};

struct Epi {
    bf16_t* Z; bf16_t* out16; int ld16;
    const float* ssq_in; float* ssq_out; float* ssqv;
    const bf16_t* xin16; bf16_t* xout16;
    const float* pool_scale; bf16_t* C16;
};
#define EPI_FENCE asm volatile("" ::: "memory")
__device__ __forceinline__ u32x4 pack8(const f32x4& v0, const f32x4& v1) { u32x4 w; w.x = cvt_pk_bf16(v0[0], v0[1]); w.y = cvt_pk_bf16(v0[2], v0[3]); w.z = cvt_pk_bf16(v1[0], v1[1]); w.w = cvt_pk_bf16(v1[2], v1[3]); return w; }
__device__ __forceinline__ float sumsq8(const f32x4& v0, const f32x4& v1) { return (v0[0] * v0[0] + v0[1] * v0[1]) + (v0[2] * v0[2] + v0[3] * v0[3]) + (v1[0] * v1[0] + v1[1] * v1[1]) + (v1[2] * v1[2] + v1[3] * v1[3]); }
__device__ __forceinline__ void epi_rstd(const float* ssq, int row0, int fq, float (&rs)[2][4]) {
    float part[2][4][4];
#pragma unroll
    for (int ai = 0; ai < 2; ++ai)
#pragma unroll
        for (int m = 0; m < 4; ++m)
#pragma unroll
            for (int j = 0; j < 4; ++j) part[ai][m][j] = ssq[(size_t)(4 * fq + j) * M + row0 + ai * 128 + m * 16];
#pragma unroll
    for (int ai = 0; ai < 2; ++ai)
#pragma unroll
        for (int m = 0; m < 4; ++m) { float t = (part[ai][m][0] + part[ai][m][1]) + (part[ai][m][2] + part[ai][m][3]); t += __shfl_xor(t, 16); t += __shfl_xor(t, 32); rs[ai][m] = __builtin_amdgcn_rsqf(t * (1.0f / 1024.0f) + EPS); }
}
template <int ACT> __device__ __forceinline__ void epi_act_store(f32x4 (&acc)[2][2][4][2], const float (&rs)[2][4], bf16_t* out, int ld, int row0, int col0, float* ssqv_slot, bool want_ssq, int fq) {
#pragma unroll
    for (int ai = 0; ai < 2; ++ai)
#pragma unroll
        for (int m = 0; m < 4; ++m) { const int row = row0 + ai * 128 + m * 16; float sq = 0.f;
#pragma unroll
            for (int bj = 0; bj < 2; ++bj) { f32x4 v0 = acc[ai][bj][m][0] * rs[ai][m], v1 = acc[ai][bj][m][1] * rs[ai][m];
                if (ACT == 1) { f32x2 a = gelu_pk((f32x2){v0[0], v0[1]}), b = gelu_pk((f32x2){v0[2], v0[3]}), c = gelu_pk((f32x2){v1[0], v1[1]}), d = gelu_pk((f32x2){v1[2], v1[3]});
                    v0 = (f32x4){a.x, a.y, b.x, b.y}; v1 = (f32x4){c.x, c.y, d.x, d.y}; sq += sumsq8(v0, v1); }
                if (ACT == 2) {
#pragma unroll
                    for (int e = 0; e < 4; ++e) { v0[e] = sigm(v0[e]); v1[e] = sigm(v1[e]); } }
                *(u32x4*)(out + (size_t)row * ld + col0 + bj * 128) = pack8(v0, v1); }
            if (ACT == 1) { if (want_ssq) { sq += __shfl_xor(sq, 16); sq += __shfl_xor(sq, 32); if (fq == 0) ssqv_slot[row] = sq; } } }
}
__device__ __forceinline__ void epi_run(const Epi& E, f32x4 (&acc)[2][2][4][2], const Unit& u, int wr, int wc, int fr, int fq) {
    const int mode = u.mode;
    const int row0 = u.pm * 256 + wr * 64 + fr, col0 = u.pn * 256 + wc * 32 + 8 * fq;
    if (mode == MODE_IN || mode == MODE_UP) {
        float rs[2][4]; epi_rstd(E.ssq_in, row0, fq, rs);
        if (mode == MODE_UP) { epi_act_store<0>(acc, rs, E.out16, E.ld16, row0, col0, nullptr, false, fq); return; }
        const int atype = u.pn >> 2;
        if (atype == 2) epi_act_store<1>(acc, rs, E.Z, NIN, row0, col0, E.ssqv + (size_t)((u.pn - 8) * 4 + wc) * M, true, fq);
        else epi_act_store<0>(acc, rs, E.Z, NIN, row0, col0, nullptr, false, fq);
    } else if (mode == MODE_POOL) {
        f32x4 sc[2][2];
#pragma unroll
        for (int bj = 0; bj < 2; ++bj) { sc[bj][0] = *(const f32x4*)(E.pool_scale + col0 + bj * 128); sc[bj][1] = *(const f32x4*)(E.pool_scale + col0 + bj * 128 + 4); }
#pragma unroll
        for (int ai = 0; ai < 2; ++ai)
#pragma unroll
            for (int m = 0; m < 4; ++m)
#pragma unroll
                for (int bj = 0; bj < 2; ++bj) *(u32x4*)(E.Z + (size_t)(row0 + ai * 128 + m * 16) * NIN + col0 + bj * 128) = pack8(acc[ai][bj][m][0] * sc[bj][0], acc[ai][bj][m][1] * sc[bj][1]);
    } else if (mode == MODE_YA) {
        u32x4 g[2][4][2];
#pragma unroll
        for (int ai = 0; ai < 2; ++ai)
#pragma unroll
            for (int m = 0; m < 4; ++m)
#pragma unroll
                for (int bj = 0; bj < 2; ++bj) g[ai][m][bj] = *(const u32x4*)(E.Z + (size_t)(row0 + ai * 128 + m * 16) * NIN + 3072 + col0 + bj * 128);
#pragma unroll
        for (int ai = 0; ai < 2; ++ai)
#pragma unroll
            for (int m = 0; m < 4; ++m)
#pragma unroll
                for (int bj = 0; bj < 2; ++bj) { const f32x4 v0 = acc[ai][bj][m][0], v1 = acc[ai][bj][m][1]; const u32x4 gg = g[ai][m][bj]; u32x4 w;
                    w.x = cvt_pk_bf16(v0[0] * sigm(bf_lo(gg.x)), v0[1] * sigm(bf_hi(gg.x))); w.y = cvt_pk_bf16(v0[2] * sigm(bf_lo(gg.y)), v0[3] * sigm(bf_hi(gg.y)));
                    w.z = cvt_pk_bf16(v1[0] * sigm(bf_lo(gg.z)), v1[1] * sigm(bf_hi(gg.z))); w.w = cvt_pk_bf16(v1[2] * sigm(bf_lo(gg.w)), v1[3] * sigm(bf_hi(gg.w)));
                    *(u32x4*)(E.Z + (size_t)(row0 + ai * 128 + m * 16) * NIN + 3072 + col0 + bj * 128) = w; }
    } else if (mode == MODE_YB) {
#pragma unroll
        for (int ai = 0; ai < 2; ++ai) { u32x4 g[4][2], c[4][2];
#pragma unroll
            for (int m = 0; m < 4; ++m)
#pragma unroll
                for (int bj = 0; bj < 2; ++bj) { const bf16_t* gp = E.Z + (size_t)(row0 + ai * 128 + m * 16) * NIN + 4096 + col0 + bj * 128; g[m][bj] = *(const u32x4*)gp; c[m][bj] = *(const u32x4*)(gp - 1024); }
#pragma unroll
            for (int m = 0; m < 4; ++m)
#pragma unroll
                for (int bj = 0; bj < 2; ++bj) { const f32x4 v0 = acc[ai][bj][m][0], v1 = acc[ai][bj][m][1]; const u32x4 gg = g[m][bj], cc = c[m][bj]; u32x4 w;
                    w.x = cvt_pk_bf16(bf_lo(cc.x) + v0[0] * sigm(bf_lo(gg.x)), bf_hi(cc.x) + v0[1] * sigm(bf_hi(gg.x))); w.y = cvt_pk_bf16(bf_lo(cc.y) + v0[2] * sigm(bf_lo(gg.y)), bf_hi(cc.y) + v0[3] * sigm(bf_hi(gg.y)));
                    w.z = cvt_pk_bf16(bf_lo(cc.z) + v1[0] * sigm(bf_lo(gg.z)), bf_hi(cc.z) + v1[1] * sigm(bf_hi(gg.z))); w.w = cvt_pk_bf16(bf_lo(cc.w) + v1[2] * sigm(bf_lo(gg.w)), bf_hi(cc.w) + v1[3] * sigm(bf_hi(gg.w)));
                    *(u32x4*)(E.Z + (size_t)(row0 + ai * 128 + m * 16) * NIN + 4096 + col0 + bj * 128) = w; }
            EPI_FENCE; }
    } else if (mode == MODE_E) {
#pragma unroll
        for (int ai = 0; ai < 2; ++ai)
#pragma unroll
            for (int m = 0; m < 4; ++m)
#pragma unroll
                for (int bj = 0; bj < 2; ++bj) *(u32x4*)(E.C16 + (size_t)(row0 + ai * 128 + m * 16) * D + col0 + bj * 128) = pack8(acc[ai][bj][m][0], acc[ai][bj][m][1]);
    } else if (mode == MODE_RES) {
        float* sslot = E.ssq_out + (size_t)(u.pn * 4 + wc) * M;
        u32x4 x[2][4][2];
#pragma unroll
        for (int ai = 0; ai < 2; ++ai)
#pragma unroll
            for (int m = 0; m < 4; ++m)
#pragma unroll
                for (int bj = 0; bj < 2; ++bj) x[ai][m][bj] = *(const u32x4*)(E.xin16 + (size_t)(row0 + ai * 128 + m * 16) * D + col0 + bj * 128);
#pragma unroll
        for (int ai = 0; ai < 2; ++ai) {
#pragma unroll
            for (int m = 0; m < 4; ++m) { const int row = row0 + ai * 128 + m * 16; float sq = 0.f;
#pragma unroll
                for (int bj = 0; bj < 2; ++bj) { const u32x4 xx = x[ai][m][bj];
                    const f32x4 x0 = (f32x4){bf_lo(xx.x), bf_hi(xx.x), bf_lo(xx.y), bf_hi(xx.y)} + acc[ai][bj][m][0], x1 = (f32x4){bf_lo(xx.z), bf_hi(xx.z), bf_lo(xx.w), bf_hi(xx.w)} + acc[ai][bj][m][1];
                    sq += sumsq8(x0, x1); *(u32x4*)(E.xout16 + (size_t)row * D + col0 + bj * 128) = pack8(x0, x1); }
                sq += __shfl_xor(sq, 16); sq += __shfl_xor(sq, 32); if (fq == 0) sslot[row] = sq; }
            EPI_FENCE; }
    } else {
        float rs[2][4]; epi_rstd(E.ssq_in, row0, fq, rs);
        float* sslot = E.ssq_out + (size_t)(u.pn * 4 + wc) * M;
#pragma unroll
        for (int ai = 0; ai < 2; ++ai)
#pragma unroll
            for (int mh = 0; mh < 2; ++mh) { u32x4 x[2][2], c[2][2];
#pragma unroll
                for (int mm = 0; mm < 2; ++mm)
#pragma unroll
                    for (int bj = 0; bj < 2; ++bj) { const size_t off = (size_t)(row0 + ai * 128 + (2 * mh + mm) * 16) * D + col0 + bj * 128; x[mm][bj] = *(const u32x4*)(E.xin16 + off); c[mm][bj] = *(const u32x4*)(E.C16 + off); }
#pragma unroll
                for (int mm = 0; mm < 2; ++mm) { const int m = 2 * mh + mm, row = row0 + ai * 128 + m * 16; float sq = 0.f;
#pragma unroll
                    for (int bj = 0; bj < 2; ++bj) { const u32x4 xx = x[mm][bj], cc = c[mm][bj];
                        const f32x4 c0 = (f32x4){bf_lo(cc.x), bf_hi(cc.x), bf_lo(cc.y), bf_hi(cc.y)}, c1 = (f32x4){bf_lo(cc.z), bf_hi(cc.z), bf_lo(cc.w), bf_hi(cc.w)};
                        f32x4 v0 = acc[ai][bj][m][0] * rs[ai][m], v1 = acc[ai][bj][m][1] * rs[ai][m];
#pragma unroll
                        for (int e = 0; e < 4; ++e) { v0[e] = sigm(v0[e]) * c0[e]; v1[e] = sigm(v1[e]) * c1[e]; }
                        const f32x4 x0 = (f32x4){bf_lo(xx.x), bf_hi(xx.x), bf_lo(xx.y), bf_hi(xx.y)} + v0, x1 = (f32x4){bf_lo(xx.z), bf_hi(xx.z), bf_lo(xx.w), bf_hi(xx.w)} + v1;
                        sq += sumsq8(x0, x1); *(u32x4*)(E.xout16 + (size_t)row * D + col0 + bj * 128) = pack8(x0, x1); }
                    sq += __shfl_xor(sq, 16); sq += __shfl_xor(sq, 32); if (fq == 0) sslot[row] = sq; }
                }
    }
}

__device__ __forceinline__ void gemm_phase(LAS unsigned char* lds, const Sched& S, const Epi& E) {
    int tid_ = threadIdx.x; asm volatile("" : "+v"(tid_));
    const int tid = tid_, wid = __builtin_amdgcn_readfirstlane(tid >> 6), lane = tid & 63, wr = wid >> 2, wc = wid & 3, fr = lane & 15, fq = lane >> 4;
    int R0, C0, R1, C1; stage_rc(tid * 16, R0, C0); stage_rc(tid * 16 + 8192, R1, C1);
    const int Rb0 = (R0 & ~31) + perm32(R0 & 31), Rb1 = (R1 & ~31) + perm32(R1 & 31);
    const size_t kstep = (size_t)(BK * 2);
    const unsigned ldsw = (unsigned)wid * 1024u;
    const int aoff = lds_byte(wr * 64 + fr, fq * 8), boff = lds_byte(wc * 32 + fr, fq * 8);
#define PG8_SA(b, h) (((b) * 2 + (h)) * HTB)
#define PG8_SB(b, h) ((4 + (b) * 2 + (h)) * HTB)
#define PG8_STAGE(bufoff, gbase, v0, v1) do { \
        __builtin_amdgcn_global_load_lds((const unsigned*)((const char*)(gbase) + (v0)), (LAS unsigned*)(lds + (bufoff) + ldsw), 16, 0, 0); \
        __builtin_amdgcn_global_load_lds((const unsigned*)((const char*)(gbase) + (v1)), (LAS unsigned*)(lds + (bufoff) + ldsw + 8192), 16, 0, 0); } while (0)
#define PG8_LDA(dst, b, h) do { _Pragma("unroll") for (int m = 0; m < 4; ++m) _Pragma("unroll") for (int k = 0; k < 2; ++k) dst[m][k] = *(const LAS bf16x8*)(lds + PG8_SA(b, h) + aoff + m * 2048 + k * 1024); } while (0)
#define PG8_LDB(dst, b, h) do { _Pragma("unroll") for (int n = 0; n < 2; ++n) _Pragma("unroll") for (int k = 0; k < 2; ++k) dst[n][k] = *(const LAS bf16x8*)(lds + PG8_SB(b, h) + boff + n * 2048 + k * 1024); } while (0)
#define PG8_MMA(ai, bj, At, Bt) do { __builtin_amdgcn_s_setprio(1); _Pragma("unroll") for (int m = 0; m < 4; ++m) _Pragma("unroll") for (int n = 0; n < 2; ++n) _Pragma("unroll") for (int k = 0; k < 2; ++k) \
        acc[ai][bj][m][n] = __builtin_amdgcn_mfma_f32_16x16x32_bf16(Bt[n][k], At[m][k], acc[ai][bj][m][n], 0, 0, 0); __builtin_amdgcn_s_setprio(0); } while (0)
#define PG8_WAIT_V(n) asm volatile("s_waitcnt vmcnt(" #n ")" ::: "memory")
#define PG8_WAIT_L(n) asm volatile("s_waitcnt lgkmcnt(" #n ")" ::: "memory")
#define PG8_BAR __builtin_amdgcn_s_barrier()
#define PG8_SCHED __builtin_amdgcn_sched_barrier(0)
    Unit cur, nxt; int ui = 0;
    if (!S.next(0, cur)) return;
    f32x4 acc[2][2][4][2];
#pragma unroll
    for (int a = 0; a < 2; ++a)
#pragma unroll
        for (int b = 0; b < 2; ++b)
#pragma unroll
            for (int m = 0; m < 4; ++m)
#pragma unroll
                for (int n = 0; n < 2; ++n) acc[a][b][m][n] = (f32x4){0.f, 0.f, 0.f, 0.f};
    bf16x8 At[4][2], B0[2][2], B1[2][2];
    const char* cA = cur.a; const char* cB = cur.b;
    const unsigned RA0 = R0 * 2, RA1 = R1 * 2, RB0 = Rb0 * 2, RB1 = Rb1 * 2, CC0 = C0 * 2, CC1 = C1 * 2;
#define PG8_STA(bufoff, gbase, ld) PG8_STAGE(bufoff, gbase, RA0 * (unsigned)(ld) + CC0, RA1 * (unsigned)(ld) + CC1)
#define PG8_STB(bufoff, gbase, ld) PG8_STAGE(bufoff, gbase, RB0 * (unsigned)(ld) + CC0, RB1 * (unsigned)(ld) + CC1)
    int lda = cur.lda, ldb = cur.ldb;
    { const size_t hA = (size_t)HALF * lda * 2, hB = (size_t)HALF * ldb * 2;
    PG8_STB(PG8_SB(0, 0), cB, ldb); PG8_STB(PG8_SB(0, 1), cB + hB, ldb); PG8_STA(PG8_SA(0, 0), cA, lda); PG8_STA(PG8_SA(0, 1), cA + hA, lda);
    if (wr == 1) PG8_BAR;
    PG8_WAIT_V(2); PG8_BAR;
    PG8_STB(PG8_SB(1, 0), cB + kstep, ldb); PG8_STA(PG8_SA(1, 0), cA + kstep, lda); PG8_STB(PG8_SB(1, 1), cB + hB + kstep, ldb);
    PG8_WAIT_V(6); PG8_BAR; }
    for (;;) {
        const bool has_next = S.next(ui + 1, nxt);
        const char* nA = has_next ? nxt.a : cA; const char* nB = has_next ? nxt.b : cB;
        const int nlda = has_next ? nxt.lda : lda, nldb = has_next ? nxt.ldb : ldb;
        const size_t hA = (size_t)HALF * lda * 2;
        const int nt = cur.nt;
        const int nt_main = has_next ? nt : nt - 2;
        for (int t = 0; t < nt_main; t += 2) {
            const bool last = (t == nt - 2);
            const char* a1 = cA + (size_t)(t + 1) * kstep;
            const char* a2 = last ? nA : cA + (size_t)(t + 2) * kstep; const char* b2 = last ? nB : cB + (size_t)(t + 2) * kstep;
            const char* a3 = a2 + kstep; const char* b3 = b2 + kstep;
            const int xlda = last ? nlda : lda, xldb = last ? nldb : ldb;
            const size_t xhA = (size_t)HALF * xlda * 2, xhB = (size_t)HALF * xldb * 2;
            PG8_LDB(B0, 0, 0); PG8_LDB(B1, 0, 1); PG8_SCHED; PG8_LDA(At, 0, 0); PG8_STA(PG8_SA(1, 1), a1 + hA, lda);
            PG8_WAIT_V(8); PG8_WAIT_L(0); PG8_BAR; PG8_MMA(0, 0, At, B0); PG8_MMA(0, 1, At, B1); PG8_BAR; PG8_SCHED;
            PG8_LDA(At, 0, 1); PG8_STB(PG8_SB(0, 0), b2, xldb); PG8_STB(PG8_SB(0, 1), b2 + xhB, xldb); PG8_STA(PG8_SA(0, 0), a2, xlda);
            PG8_WAIT_V(8); PG8_WAIT_L(0); PG8_BAR; PG8_MMA(1, 0, At, B0); PG8_MMA(1, 1, At, B1); PG8_BAR; PG8_SCHED;
            PG8_LDB(B0, 1, 0); PG8_LDB(B1, 1, 1); PG8_SCHED; PG8_LDA(At, 1, 0); PG8_STA(PG8_SA(0, 1), a2 + xhA, xlda);
            PG8_WAIT_V(8); PG8_WAIT_L(0); PG8_BAR; PG8_MMA(0, 0, At, B0); PG8_MMA(0, 1, At, B1); PG8_BAR; PG8_SCHED;
            PG8_LDA(At, 1, 1); PG8_STB(PG8_SB(1, 0), b3, xldb); PG8_STB(PG8_SB(1, 1), b3 + xhB, xldb); PG8_STA(PG8_SA(1, 0), a3, xlda);
            PG8_WAIT_V(8); PG8_WAIT_L(0); PG8_BAR; PG8_MMA(1, 0, At, B0); PG8_MMA(1, 1, At, B1); PG8_BAR; PG8_SCHED;
        }
        if (!has_next) {
            const char* a1 = cA + (size_t)(nt - 1) * kstep;
            PG8_LDB(B0, 0, 0); PG8_LDB(B1, 0, 1); PG8_SCHED; PG8_LDA(At, 0, 0); PG8_STA(PG8_SA(1, 1), a1 + hA, lda);
            PG8_WAIT_V(8); PG8_WAIT_L(0); PG8_BAR; PG8_MMA(0, 0, At, B0); PG8_MMA(0, 1, At, B1); PG8_BAR; PG8_SCHED;
            PG8_LDA(At, 0, 1);
            PG8_WAIT_V(2); PG8_WAIT_L(0); PG8_BAR; PG8_MMA(1, 0, At, B0); PG8_MMA(1, 1, At, B1); PG8_BAR; PG8_SCHED;
            PG8_LDB(B0, 1, 0); PG8_LDB(B1, 1, 1); PG8_SCHED; PG8_LDA(At, 1, 0);
            PG8_WAIT_V(0); PG8_WAIT_L(0); PG8_BAR; PG8_MMA(0, 0, At, B0); PG8_MMA(0, 1, At, B1); PG8_BAR; PG8_SCHED;
            PG8_LDA(At, 1, 1);
            PG8_WAIT_L(0); PG8_BAR; PG8_MMA(1, 0, At, B0); PG8_MMA(1, 1, At, B1); PG8_BAR; PG8_SCHED;
        }
        if (wr == 0) PG8_BAR;
        epi_run(E, acc, cur, wr, wc, fr, fq);
        if (!has_next) break;
#pragma unroll
        for (int a = 0; a < 2; ++a)
#pragma unroll
            for (int b = 0; b < 2; ++b)
#pragma unroll
                for (int m = 0; m < 4; ++m)
#pragma unroll
                    for (int n = 0; n < 2; ++n) acc[a][b][m][n] = (f32x4){0.f, 0.f, 0.f, 0.f};
        cur = nxt; cA = nA; cB = nB; lda = nlda; ldb = nldb; ++ui;
        if (wr == 1) PG8_BAR;
    }
#undef PG8_STA
#undef PG8_STB
    PG8_WAIT_V(0);
    PG8_BAR;
#undef PG8_SA
#undef PG8_SB
#undef PG8_STAGE
#undef PG8_LDA
#undef PG8_LDB
#undef PG8_MMA
#undef PG8_WAIT_V
#undef PG8_WAIT_L
#undef PG8_BAR
#undef PG8_SCHED
}

struct Params { const float* in[21]; float* out; unsigned char* ws; int ph_lo, ph_hi; };
typedef const __attribute__((address_space(4))) Params* KP;
__device__ __forceinline__ KP kparams() { KP k = (KP)__builtin_amdgcn_kernarg_segment_ptr(); asm volatile("" : "+s"(k)); return k; }
enum { I_X = 0, I_P, I_MIXN, I_WIN, I_WPOOL, I_PSCALE, I_SGUN, I_WSP, I_BSP, I_WA, I_WB, I_WO, I_FFNN, I_WUP, I_CONVW, I_CONVB, I_WDN, I_PLEN, I_WPG, I_WPLE, I_FINN };

__device__ __forceinline__ void transpose_item(const float* W, const float* gain, int K, int N, bf16_t* WT, int row_off, LAS float* scr, int item, int lane) {
    const int nblk = N / 32, kb = item / nblk, nb = item % nblk, k0 = 64 * kb, n0 = 32 * nb;
    float tv[32];
#pragma unroll
    for (int i = 0; i < 32; ++i) { const int kk = 2 * i + (lane >> 5); tv[i] = W[(size_t)(k0 + kk) * N + n0 + (lane & 31)]; }
    if (gain) {
#pragma unroll
        for (int i = 0; i < 32; ++i) tv[i] *= gain[k0 + 2 * i + (lane >> 5)]; }
#pragma unroll
    for (int i = 0; i < 32; ++i) scr[(2 * i + (lane >> 5)) * 33 + (lane & 31)] = tv[i];
    asm volatile("s_waitcnt lgkmcnt(0)" ::: "memory");
    const int c = lane & 7;
#pragma unroll
    for (int j = 0; j < 4; ++j) { const int n = (lane >> 3) + 8 * j; const LAS float* s = scr + (8 * c) * 33 + n;
        u32x4 o; o.x = cvt_pk_bf16(s[0 * 33], s[1 * 33]); o.y = cvt_pk_bf16(s[2 * 33], s[3 * 33]); o.z = cvt_pk_bf16(s[4 * 33], s[5 * 33]); o.w = cvt_pk_bf16(s[6 * 33], s[7 * 33]);
        *(u32x4*)(WT + (size_t)(row_off + n0 + n) * K + k0 + 8 * c) = o; }
    asm volatile("s_waitcnt lgkmcnt(0)" ::: "memory");
}

enum { WM_IN = 1, WM_POOL = 2, WM_A = 4, WM_B = 8, WM_O = 16, WM_UP = 32, WM_DN = 64, WM_PG = 128, WM_PLE = 256 };
__device__ __forceinline__ void prep_weights(KP kp, LAS unsigned char* lds, int l, int mask, int first_wg, int n_wg) {
    unsigned char* ws = kp->ws;
    int tid_ = threadIdx.x; asm volatile("" : "+v"(tid_));
    const int lane = tid_ & 63, wave = tid_ >> 6;
    if ((int)blockIdx.x < first_wg) return;
    LAS float* scr = (LAS float*)(lds + wave * 16384);
    const int gw = ((int)blockIdx.x - first_wg) * 8 + wave, NGW = n_wg * 8;
    constexpr int I_IN = (D / 64) * (NIN / 32), I_PL = (256 / 64) * (256 / 32), I_SQ = (D / 64) * (D / 32), I_UP = (D / 64) * (NUP / 32), I_DN = (FF / 64) * (D / 32), I_PE = (PLE / 64) * (D / 32);
    const int n_in = (mask & WM_IN) ? I_IN : 0, n_pl = (mask & WM_POOL) ? 4 * I_PL : 0, n_a = (mask & WM_A) ? I_SQ : 0, n_b = (mask & WM_B) ? I_SQ : 0, n_o = (mask & WM_O) ? I_SQ : 0,
              n_up = (mask & WM_UP) ? I_UP : 0, n_dn = (mask & WM_DN) ? I_DN : 0, n_pg = (mask & WM_PG) ? I_SQ : 0, n_pe = (mask & WM_PLE) ? I_PE : 0;
    const int nitems = n_in + n_pl + n_a + n_b + n_o + n_up + n_dn + n_pg + n_pe;
    for (int it = gw; it < nitems; it += NGW) {
        int r = it;
        if (r < n_in) { transpose_item(kp->in[I_WIN] + (size_t)l * D * NIN, kp->in[I_MIXN] + l * D, D, NIN, (bf16_t*)(ws + W_IN), 0, scr, r, lane); continue; } r -= n_in;
        if (r < n_pl) { const int g = r / I_PL; transpose_item(kp->in[I_WPOOL] + ((size_t)l * 4 + g) * 256 * 256, nullptr, 256, 256, (bf16_t*)(ws + W_POOL), g * 256, scr, r % I_PL, lane); continue; } r -= n_pl;
        if (r < n_a) { transpose_item(kp->in[I_WA] + (size_t)l * D * D, nullptr, D, D, (bf16_t*)(ws + W_A), 0, scr, r, lane); continue; } r -= n_a;
        if (r < n_b) { transpose_item(kp->in[I_WB] + (size_t)l * D * D, nullptr, D, D, (bf16_t*)(ws + W_B), 0, scr, r, lane); continue; } r -= n_b;
        if (r < n_o) { transpose_item(kp->in[I_WO] + (size_t)l * D * D, nullptr, D, D, (bf16_t*)(ws + W_O), 0, scr, r, lane); continue; } r -= n_o;
        if (r < n_up) { transpose_item(kp->in[I_WUP] + (size_t)l * D * NUP, kp->in[I_FFNN] + l * D, D, NUP, (bf16_t*)(ws + W_UP), 0, scr, r, lane); continue; } r -= n_up;
        if (r < n_dn) { transpose_item(kp->in[I_WDN] + (size_t)l * FF * D, nullptr, FF, D, (bf16_t*)(ws + W_DN), 0, scr, r, lane); continue; } r -= n_dn;
        if (r < n_pg) { transpose_item(kp->in[I_WPG] + (size_t)l * D * D, kp->in[I_PLEN] + l * D, D, D, (bf16_t*)(ws + W_PG), 0, scr, r, lane); continue; } r -= n_pg;
        transpose_item(kp->in[I_WPLE] + (size_t)l * PLE * D, nullptr, PLE, D, (bf16_t*)(ws + W_PLE), 0, scr, r, lane);
    }
}
__device__ __forceinline__ void prep_phase(KP kp, LAS unsigned char* lds, int l) {
    unsigned char* ws = kp->ws;
    prep_weights(kp, lds, l, WM_IN | WM_POOL, 0, gridDim.x);
    int tid_ = threadIdx.x; asm volatile("" : "+v"(tid_));
    const int tid = tid_, lane = tid & 63, wave = tid >> 6;
    const int gw = blockIdx.x * 8 + wave, NGW = gridDim.x * 8;
    { const float* wsp = kp->in[I_WSP] + (size_t)l * 8 * 128 * 128; bf16_t* o = (bf16_t*)(ws + W_S16);
      for (int i = blockIdx.x * 512 + tid; i < 8 * 128 * 128 / 2; i += gridDim.x * 512) { const int e = 2 * i, s = e & 127, t = (e >> 7) & 127;
          const f32x2 v = *(const f32x2*)(wsp + e); *(unsigned*)(o + e) = cvt_pk_bf16(s <= t ? v.x : 0.f, (s + 1) <= t ? v.y : 0.f); } }
    const float* xsrc = kp->in[I_X]; bf16_t* XB = (bf16_t*)(ws + ws_xb(0)); float* ssqa = (float*)(ws + WS_SSQA);
    if (l == 0) for (int m = gw; m < M; m += 4 * NGW) {
        f32x4 v[4][4];
#pragma unroll
        for (int r = 0; r < 4; ++r) { const int mm = m + r * NGW; if (mm < M) { const f32x4* xr = (const f32x4*)(xsrc + (size_t)mm * D) + lane;
#pragma unroll
            for (int j = 0; j < 4; ++j) v[r][j] = xr[64 * j]; } }
#pragma unroll
        for (int r = 0; r < 4; ++r) { const int mm = m + r * NGW; if (mm < M) { float sacc = 0.f;
#pragma unroll
            for (int j = 0; j < 4; ++j) sacc += (v[r][j].x * v[r][j].x + v[r][j].y * v[r][j].y) + (v[r][j].z * v[r][j].z + v[r][j].w * v[r][j].w);
            u32x2* o8 = (u32x2*)(XB + (size_t)mm * D) + lane;
#pragma unroll
            for (int j = 0; j < 4; ++j) { u32x2 w; w.x = cvt_pk_bf16(v[r][j].x, v[r][j].y); w.y = cvt_pk_bf16(v[r][j].z, v[r][j].w); o8[64 * j] = w; }
            const float tot = wave_sum(sacc); if (lane < 16) ssqa[(size_t)lane * M + mm] = (lane == 0) ? tot : 0.f; } }
    }
}

__device__ __forceinline__ void unpack8(const u32x4& r, float (&v)[8]) { v[0] = bf_lo(r.x); v[1] = bf_hi(r.x); v[2] = bf_lo(r.y); v[3] = bf_hi(r.y); v[4] = bf_lo(r.z); v[5] = bf_hi(r.z); v[6] = bf_lo(r.w); v[7] = bf_hi(r.w); }
__device__ __forceinline__ void sgu_phase(KP kp, LAS unsigned char* lds, int l) {
    unsigned char* ws = kp->ws; bf16_t* Z = (bf16_t*)(ws + ws_big(l)); const float* ssqv = (const float*)(ws + WS_SSQV); const bf16_t* ws16 = (const bf16_t*)(ws + W_S16);
    const float* bsp = kp->in[I_BSP] + l * 8 * 128; const float* gn = kp->in[I_SGUN] + l * D;
    int tid_ = threadIdx.x; asm volatile("" : "+v"(tid_));
    const int tid = tid_, wid = tid >> 6, lane = tid & 63, fr = lane & 15, fq = lane >> 4;
    LAS float* rsd = (LAS float*)(lds + 40960);
    const bool local_map = (gridDim.x == 256);
    int pm_ = 0, pn_ = 0;
    { const int c = blockIdx.x, wgid = (c % 8) * 32 + c / 8; pm_ = (wgid / 32) * 8 + ((wgid % 32) % 8); pn_ = (wgid % 32) / 8; }
    const int n_units = local_map ? 4 : (1024 - (int)blockIdx.x + (int)gridDim.x - 1) / (int)gridDim.x;
    for (int ui = 0; ui < n_units; ++ui) {
        const int u = local_map ? ((2 * pm_ + (ui >> 1)) * 8 + 2 * pn_ + (ui & 1)) : ((int)blockIdx.x + ui * (int)gridDim.x);
        const int h = u & 7, r0 = (u >> 3) * 128;
        if (tid < 128) { float s = 0.f;
#pragma unroll
            for (int j = 0; j < 16; ++j) s += ssqv[(size_t)j * M + r0 + tid];
            rsd[tid] = __builtin_amdgcn_rsqf(s * (1.0f / 1024.0f) + EPS); }
        __syncthreads();
        { const int dc = tid & 15; const f32x4 g0 = *(const f32x4*)(gn + h * 128 + dc * 8), g1 = *(const f32x4*)(gn + h * 128 + dc * 8 + 4);
#pragma unroll
          for (int j = 0; j < 4; ++j) { const int s = (tid >> 4) + 32 * j; const u32x4 raw = *(const u32x4*)(Z + (size_t)(r0 + s) * NIN + 2048 + h * 128 + dc * 8); const float r = rsd[s];
              u32x4 wv; wv.x = cvt_pk_bf16(bf_lo(raw.x) * r * g0.x, bf_hi(raw.x) * r * g0.y); wv.y = cvt_pk_bf16(bf_lo(raw.y) * r * g0.z, bf_hi(raw.y) * r * g0.w);
              wv.z = cvt_pk_bf16(bf_lo(raw.z) * r * g1.x, bf_hi(raw.z) * r * g1.y); wv.w = cvt_pk_bf16(bf_lo(raw.w) * r * g1.z, bf_hi(raw.w) * r * g1.w);
              *(LAS u32x4*)(lds + 256 * s + 16 * (dc ^ (((s & 3) << 2) | ((s >> 2) & 3)))) = wv; } }
        __syncthreads();
        const int kkmax = (16 * wid + 15) >> 5;
        bf16x8 wfa[4];
#pragma unroll
        for (int kk = 0; kk < 4; ++kk) wfa[kk] = (kk <= kkmax) ? *(const bf16x8*)(ws16 + (size_t)(h * 128 + 16 * wid + fr) * 128 + 32 * kk + 8 * fq) : (bf16x8){0, 0, 0, 0, 0, 0, 0, 0};
        const int t = 16 * wid + fr; const float bias = bsp[h * 128 + t]; bf16_t* up = Z + (size_t)(r0 + t) * NIN + 1024 + h * 128 + 4 * fq;
        u32x2 uu[8];
#pragma unroll
        for (int n = 0; n < 8; ++n) uu[n] = *(const u32x2*)(up + 16 * n);
        { const int w = 2 << (h >> 1), pc = tid & 15, pr = (tid >> 4) * 4, t0 = (r0 + pr) & (SEQ - 1);
          const bf16_t* src = Z + (size_t)(r0 + pr) * NIN + h * 128 + pc * 8;
          float ps[8];
#pragma unroll
          for (int e = 0; e < 8; ++e) ps[e] = 0.f;
          { u32x4 hw[15];
#pragma unroll
            for (int j = 1; j < 16; ++j) hw[j - 1] = (j < w && t0 - j >= 0) ? *(const u32x4*)(src - (size_t)j * NIN) : (u32x4){0u, 0u, 0u, 0u};
#pragma unroll
            for (int j = 0; j < 15; ++j) { float v[8]; unpack8(hw[j], v);
#pragma unroll
                for (int e = 0; e < 8; ++e) ps[e] += v[e]; } }
#pragma unroll
          for (int i = 0; i < 4; ++i) {
              float cur[8]; unpack8(*(const u32x4*)(src + (size_t)i * NIN), cur);
              const int t = t0 + i, n = (t + 1 < w) ? t + 1 : w; const float inv = 1.0f / (float)n;
              float o[8];
#pragma unroll
              for (int e = 0; e < 8; ++e) { ps[e] += cur[e]; o[e] = ps[e] * inv - cur[e]; }
              u32x4 ov; ov.x = cvt_pk_bf16(o[0], o[1]); ov.y = cvt_pk_bf16(o[2], o[3]); ov.z = cvt_pk_bf16(o[4], o[5]); ov.w = cvt_pk_bf16(o[6], o[7]);
              *(u32x4*)(Z + (size_t)(r0 + pr + i) * NIN + 2048 + h * 128 + pc * 8) = ov;
              if (t - w + 1 >= 0) { float old[8]; unpack8(*(const u32x4*)(src + (ptrdiff_t)(i - w + 1) * NIN), old);
#pragma unroll
                  for (int e = 0; e < 8; ++e) ps[e] -= old[e]; }
          } }
        f32x4 acc[8];
#pragma unroll
        for (int n = 0; n < 8; ++n) acc[n] = (f32x4){0.f, 0.f, 0.f, 0.f};
#pragma unroll
        for (int kk = 0; kk < 4; ++kk) {
            if (kk <= kkmax) {
#pragma unroll
                for (int n = 0; n < 8; ++n) {
                    const int q_ = fr >> 2, p_ = fr & 3, rowb = 32 * kk + 8 * fq + q_, chb = 2 * n + (p_ >> 1);
                    const int a0 = 256 * rowb + 16 * (chb ^ ((q_ << 2) | ((2 * fq) & 3))) + 8 * (p_ & 1), a1 = 256 * (rowb + 4) + 16 * (chb ^ ((q_ << 2) | ((2 * fq + 1) & 3))) + 8 * (p_ & 1);
                    typedef short s16x4_t __attribute__((ext_vector_type(4)));
                    const s16x4_t lo = __builtin_amdgcn_ds_read_tr16_b64_v4i16((LAS s16x4_t*)(lds + a0)), hi = __builtin_amdgcn_ds_read_tr16_b64_v4i16((LAS s16x4_t*)(lds + a1));
                    const bf16x8 vf = (bf16x8){lo[0], lo[1], lo[2], lo[3], hi[0], hi[1], hi[2], hi[3]};
                    acc[n] = __builtin_amdgcn_mfma_f32_16x16x32_bf16(vf, wfa[kk], acc[n], 0, 0, 0); }
            }
        }
#pragma unroll
        for (int n = 0; n < 8; ++n) { u32x2 w;
            const f32x2 ua = gelu_pk((f32x2){bf_lo(uu[n].x), bf_hi(uu[n].x)}), ub = gelu_pk((f32x2){bf_lo(uu[n].y), bf_hi(uu[n].y)});
            w.x = cvt_pk_bf16(ua.x * (acc[n][0] + bias), ua.y * (acc[n][1] + bias)); w.y = cvt_pk_bf16(ub.x * (acc[n][2] + bias), ub.y * (acc[n][3] + bias));
            *(u32x2*)(up + 16 * n) = w; }
        __syncthreads();
    }
}

__device__ __forceinline__ void conv_phase(KP kp, int l, int a0t, int na) {
    const bf16_t* UPP = (const bf16_t*)(kp->ws + ws_big(l)); bf16_t* ACT = (bf16_t*)(kp->ws + ws_big(l) + 96 * MiB);
    const float* cw = kp->in[I_CONVW] + (size_t)l * 3 * NUP; const float* cb = kp->in[I_CONVB] + (size_t)l * NUP;
    const int nchunk = na * 32, ldu = 2 * na * 256, total = (M / 8) * nchunk, NT = gridDim.x * 512;
    int tid_ = threadIdx.x; asm volatile("" : "+v"(tid_));
    for (int idx = blockIdx.x * 512 + tid_; idx < total; idx += NT) {
        const int chunk = idx % nchunk, row0 = (idx / nchunk) * 8, t0 = row0 & (SEQ - 1), ca = chunk * 8, j = a0t * 256 + ca;
        float wa[3][8], wb[3][8], ba[8], bb[8];
#pragma unroll
        for (int k = 0; k < 3; ++k) { const float* wk = cw + (size_t)k * NUP + j; const f32x4 a0 = *(const f32x4*)wk, a1 = *(const f32x4*)(wk + 4), b0 = *(const f32x4*)(wk + FF), b1 = *(const f32x4*)(wk + FF + 4);
#pragma unroll
            for (int e = 0; e < 4; ++e) { wa[k][e] = a0[e]; wa[k][4 + e] = a1[e]; wb[k][e] = b0[e]; wb[k][4 + e] = b1[e]; } }
        { const f32x4 a0 = *(const f32x4*)(cb + j), a1 = *(const f32x4*)(cb + j + 4), b0 = *(const f32x4*)(cb + FF + j), b1 = *(const f32x4*)(cb + FF + j + 4);
#pragma unroll
          for (int e = 0; e < 4; ++e) { ba[e] = a0[e]; ba[4 + e] = a1[e]; bb[e] = b0[e]; bb[4 + e] = b1[e]; } }
        const bf16_t* src = UPP + (size_t)row0 * ldu + ca;
        u32x4 ra[10], rb[10];
#pragma unroll
        for (int i = 0; i < 10; ++i) { if (i >= 2 || t0 > 0) { ra[i] = *(const u32x4*)(src + (ptrdiff_t)(i - 2) * ldu); rb[i] = *(const u32x4*)(src + (ptrdiff_t)(i - 2) * ldu + na * 256); }
                                       else { ra[i] = (u32x4){0u, 0u, 0u, 0u}; rb[i] = (u32x4){0u, 0u, 0u, 0u}; } }
#pragma unroll
        for (int i = 0; i < 8; ++i) {
            float va[8], vb[8];
#pragma unroll
            for (int e = 0; e < 8; ++e) { va[e] = ba[e]; vb[e] = bb[e]; }
#pragma unroll
            for (int k = 0; k < 3; ++k) { float xa[8], xb[8]; unpack8(ra[i + k], xa); unpack8(rb[i + k], xb);
#pragma unroll
                for (int e = 0; e < 8; ++e) { va[e] += wa[k][e] * xa[e]; vb[e] += wb[k][e] * xb[e]; } }
            u32x4 o; { f32x2 gg;
                gg = gelu_pk((f32x2){va[0], va[1]}); o.x = cvt_pk_bf16(gg.x * vb[0], gg.y * vb[1]); gg = gelu_pk((f32x2){va[2], va[3]}); o.y = cvt_pk_bf16(gg.x * vb[2], gg.y * vb[3]);
                gg = gelu_pk((f32x2){va[4], va[5]}); o.z = cvt_pk_bf16(gg.x * vb[4], gg.y * vb[5]); gg = gelu_pk((f32x2){va[6], va[7]}); o.w = cvt_pk_bf16(gg.x * vb[6], gg.y * vb[7]); }
            *(u32x4*)(ACT + (size_t)(row0 + i) * FF + j) = o;
        }
    }
}

__device__ __forceinline__ void pb_convert(KP kp, int l, int first_wg, int n_wg) {
    const float* src = kp->in[I_P] + (size_t)l * M * PLE; bf16_t* PB = (bf16_t*)(kp->ws + ws_big(l) + 80 * MiB);
    const int NT = n_wg * 512;
    int tid_ = threadIdx.x; asm volatile("" : "+v"(tid_));
    if ((int)blockIdx.x < first_wg) return;
    for (int idx = ((int)blockIdx.x - first_wg) * 512 + tid_; idx < M * PLE / 8; idx += NT) {
        const f32x4 a = *(const f32x4*)(src + (size_t)idx * 8), b = *(const f32x4*)(src + (size_t)idx * 8 + 4);
        u32x4 o; o.x = cvt_pk_bf16(a.x, a.y); o.y = cvt_pk_bf16(a.z, a.w); o.z = cvt_pk_bf16(b.x, b.y); o.w = cvt_pk_bf16(b.z, b.w);
        *(u32x4*)(PB + (size_t)idx * 8) = o;
    }
}

__device__ __forceinline__ void final_phase(KP kp, const float* ssq, const bf16_t* XF) {
    int tid_ = threadIdx.x; asm volatile("" : "+v"(tid_));
    const int tid = tid_, lane = tid & 63, wave = tid >> 6, gw = blockIdx.x * 8 + wave, NGW = gridDim.x * 8;
    const float* g = kp->in[I_FINN];
    f32x4 gv[2][2];
#pragma unroll
    for (int j = 0; j < 2; ++j) { gv[j][0] = *(const f32x4*)(g + (lane + 64 * j) * 8); gv[j][1] = *(const f32x4*)(g + (lane + 64 * j) * 8 + 4); }
    for (int m = gw; m < M; m += 2 * NGW) {
        const int m1 = m + NGW;
        const float p0 = (lane < 16) ? ssq[(size_t)lane * M + m] : 0.f, p1 = (lane < 16) ? ssq[(size_t)lane * M + m1] : 0.f;
        u32x4 v[2][2];
#pragma unroll
        for (int j = 0; j < 2; ++j) { v[0][j] = *((const u32x4*)(XF + (size_t)m * D) + lane + 64 * j); v[1][j] = *((const u32x4*)(XF + (size_t)m1 * D) + lane + 64 * j); }
        const float rs0 = __builtin_amdgcn_rsqf(wave_sum(p0) * (1.0f / 1024.0f) + EPS), rs1 = __builtin_amdgcn_rsqf(wave_sum(p1) * (1.0f / 1024.0f) + EPS);
#pragma unroll
        for (int r = 0; r < 2; ++r) { const float rs = r ? rs1 : rs0; float* orow = kp->out + (size_t)(r ? m1 : m) * D;
#pragma unroll
            for (int j = 0; j < 2; ++j) { const u32x4 xx = v[r][j];
                *(f32x4*)(orow + (lane + 64 * j) * 8) = (f32x4){bf_lo(xx.x), bf_hi(xx.x), bf_lo(xx.y), bf_hi(xx.y)} * rs * gv[j][0];
                *(f32x4*)(orow + (lane + 64 * j) * 8 + 4) = (f32x4){bf_lo(xx.z), bf_hi(xx.z), bf_lo(xx.w), bf_hi(xx.w)} * rs * gv[j][1]; } }
    }
}

#define XB_TMO      128
#define XB_XCNT(j)  (256  + 64 * (j))
#define XB_XSUB(j)  (1280 + 64 * (j))
#define XB_XGEN(j)  (2304 + 64 * (j))
#define XB_TOP      3328
#define XB_TOPGEN   3392
#define XCD_BAR_WORDS 3456
#define XB_SPIN_CAP (1u << 18)

__device__ __forceinline__ unsigned xb_ld(unsigned* p)              { return __hip_atomic_load(p, __ATOMIC_RELAXED, __HIP_MEMORY_SCOPE_AGENT); }
__device__ __forceinline__ unsigned xb_add(unsigned* p, unsigned v) { return __hip_atomic_fetch_add(p, v, __ATOMIC_RELAXED, __HIP_MEMORY_SCOPE_AGENT); }
__device__ __forceinline__ unsigned xb_xcc_id() { return (unsigned)__builtin_amdgcn_s_getreg((3 << 11) | 20) & 0xFu; }
#define XB_SPIN(cond, bar) do { unsigned _sp = 0; while (cond) { __builtin_amdgcn_s_sleep(1); \
    if ((++_sp & 255u) == 0u) { if (xb_ld(&(bar)[XB_TMO])) break; if (_sp > XB_SPIN_CAP) { atomicAdd(&(bar)[XB_TMO], 1u); break; } } } } while (0)

struct XcdBarrier {
    unsigned* bar; unsigned x;
    volatile LAS unsigned* st;
};

__device__ __forceinline__ XcdBarrier xcd_barrier_post(unsigned* bar, volatile LAS unsigned* st) {
    XcdBarrier b; b.bar = bar; b.x = xb_xcc_id(); b.st = st;
    if (threadIdx.x == 0) (void)xb_add(&bar[XB_XCNT(b.x)], 1u);
    return b;
}
__device__ __forceinline__ void xcd_barrier_complete(unsigned* bar, unsigned x, unsigned& nloc, unsigned& nx) {
    const unsigned G = gridDim.x * gridDim.y * gridDim.z;
    unsigned sum, cnt, mine, sp = 0u;
    for (;;) {
        sum = 0u; cnt = 0u; mine = 0u;
#pragma unroll
        for (unsigned j = 0; j < 16; ++j) { const unsigned c = xb_ld(&bar[XB_XCNT(j)]); sum += c; cnt += (c > 0u) ? 1u : 0u; mine = (j == x) ? c : mine; }
        if (sum == G) break;
        __builtin_amdgcn_s_sleep(1);
        if ((++sp & 255u) == 0u) { if (xb_ld(&bar[XB_TMO])) break; if (sp > XB_SPIN_CAP) { atomicAdd(&bar[XB_TMO], 1u); break; } }
    }
    nloc = mine > 0u ? mine : 1u; nx = cnt > 0u ? cnt : 1u;
}

__device__ __forceinline__ void xcd_barrier(const XcdBarrier& b) {
    asm volatile("s_waitcnt vmcnt(0)" ::: "memory");
    __syncthreads();
    if (threadIdx.x == 0) {
        unsigned* bar = b.bar;
        __builtin_amdgcn_s_waitcnt(0);
        unsigned nloc = b.st[0], nx = b.st[1];
        if (nloc == 0u) { xcd_barrier_complete(bar, b.x, nloc, nx); b.st[0] = nloc; b.st[1] = nx; }
        const unsigned old = xb_add(&bar[XB_XSUB(b.x)], 1u);
        const unsigned gen = old / nloc;
        if (old + 1u == (gen + 1u) * nloc) {
            __builtin_amdgcn_fence(__ATOMIC_RELEASE, "agent");
            asm volatile("s_waitcnt vmcnt(0)" ::: "memory");
            const unsigned og = xb_add(&bar[XB_TOP], 1u);
            const unsigned tg = og / nx;
            __builtin_amdgcn_fence(__ATOMIC_ACQUIRE, "agent");
            if (og + 1u == (tg + 1u) * nx) xb_add(&bar[XB_TOPGEN], 1u);
            else XB_SPIN(xb_ld(&bar[XB_TOPGEN]) == tg, bar);
            xb_add(&bar[XB_XGEN(b.x)], 1u);
            asm volatile("s_waitcnt vmcnt(0)" ::: "memory");
        } else {
            __builtin_amdgcn_fence(__ATOMIC_ACQUIRE, "agent");
            XB_SPIN(xb_ld(&bar[XB_XGEN(b.x)]) == gen, bar);
            asm volatile("s_waitcnt vmcnt(0)" ::: "memory");
        }
    }
    __syncthreads();
}


constexpr int PH_PER_LAYER = 13, N_PHASES = 2 * PH_PER_LAYER + 1;
__global__ void __launch_bounds__(512) fwd_kernel(Params p) {
    extern __shared__ __attribute__((aligned(16))) unsigned char lds_raw[];
    LAS unsigned char* lds = (LAS unsigned char*)lds_raw;
    cg::grid_group grid = cg::this_grid();
    if (threadIdx.x < 64) ((LAS unsigned*)(lds + 131072))[threadIdx.x] = 0u;
    __syncthreads();
    XcdBarrier xbar = xcd_barrier_post((unsigned*)(kparams()->ws + WS_CTL), (volatile LAS unsigned*)(lds + 131072 + 64));
    for (int ph = p.ph_lo; ph < p.ph_hi; ++ph) {
        KP kp = kparams();
        unsigned char* ws = kp->ws;
        const int l_ = ph / PH_PER_LAYER;
        bf16_t* Z = (bf16_t*)(ws + ws_big(l_)); bf16_t* XB = (bf16_t*)(ws + ws_xb(l_));
        float* ssqA = (float*)(ws + WS_SSQA); float* ssqB = (float*)(ws + WS_SSQB);
        const int l = ph / PH_PER_LAYER, k = ph % PH_PER_LAYER;
        if (ph == N_PHASES - 1) { final_phase(kp, ssqA, (const bf16_t*)(ws + ws_big(1) + 96 * MiB)); break; }
        float* sa = (l == 0) ? ssqA : ssqB; float* sb = (l == 0) ? ssqB : ssqA;
        bool is_gemm = false;
        Sched S; Epi E;
        S.nsub = 1; S.nN = 4; S.G = gridDim.x; S.c = blockIdx.x;
        S.s0 = SubG{nullptr, nullptr, D, D, D, MODE_RES, 0, 1 << 30, 0}; S.s1 = S.s0;
        E.Z = Z; E.out16 = Z; E.ld16 = NIN; E.ssq_in = sa; E.ssq_out = sb; E.ssqv = (float*)(ws + WS_SSQV);
        E.xin16 = XB; E.xout16 = XB; E.pool_scale = kp->in[I_PSCALE] + l * D; E.C16 = (bf16_t*)(ws + ws_big(l) + 8 * MiB);
        switch (k) {
        case 0: prep_phase(kp, lds, l); break;
        case 1: S.nN = 20; S.s0 = SubG{XB, (const bf16_t*)(ws + W_IN), D, D, D, MODE_IN, 0, 1 << 30, 0}; E.ssq_in = sa; is_gemm = true; break;
        case 2: sgu_phase(kp, lds, l); break;
        case 3: break;
        case 4: S.nN = 4; S.s0 = SubG{Z + 2048, (const bf16_t*)(ws + W_POOL), NIN, 256, 256, MODE_POOL, 256, 1 << 30, 0}; is_gemm = true; break;
        case 5: S.nN = 4; S.nsub = 2; S.s0 = SubG{Z, (const bf16_t*)(ws + W_A), NIN, D, D, MODE_YA, 0, 1 << 30, 0};
                S.s1 = SubG{Z + 1024, (const bf16_t*)(ws + W_B), NIN, D, D, MODE_YB, 0, 1 << 30, 0}; is_gemm = true; break;
        case 6: S.nN = 4; S.s0 = SubG{Z + 4096, (const bf16_t*)(ws + W_O), NIN, D, D, MODE_RES, 0, 1 << 30, 0};
                E.ssq_out = sb; is_gemm = true; break;
        case 7: S.nN = 12; S.s0 = SubG{XB, (const bf16_t*)(ws + W_UP), D, D, D, MODE_UP, 0, 6, 5}; E.ssq_in = sb; E.out16 = (bf16_t*)(ws + ws_big(l)); E.ld16 = 3072; is_gemm = true; break;
        case 8: conv_phase(kp, l, 0, 6); break;
        case 9: S.nN = 10; S.s0 = SubG{XB, (const bf16_t*)(ws + W_UP) + (size_t)6 * 256 * D, D, D, D, MODE_UP, 0, 5, 6}; E.ssq_in = sb; E.out16 = (bf16_t*)(ws + ws_big(l)); E.ld16 = 2560; is_gemm = true; break;
        case 10: conv_phase(kp, l, 6, 5); break;
        case 11:
                 S.nN = 4; S.s0 = SubG{(const bf16_t*)(ws + ws_big(l) + 96 * MiB), (const bf16_t*)(ws + W_DN), FF, FF, FF, MODE_RES, 0, 1 << 30, 0}; E.ssq_out = sa; is_gemm = true; break;
        case 12: S.nN = 4; S.nsub = 2; S.s0 = SubG{(const bf16_t*)(ws + ws_big(l) + 80 * MiB), (const bf16_t*)(ws + W_PLE), PLE, PLE, PLE, MODE_E, 0, 1 << 30, 0};
                 S.s1 = SubG{XB, (const bf16_t*)(ws + W_PG), D, D, D, MODE_PLE, 0, 1 << 30, 0}; E.ssq_in = sa; E.ssq_out = sb; E.xout16 = (l == 0) ? (bf16_t*)(ws + ws_xb(1)) : (bf16_t*)(ws + ws_big(1) + 96 * MiB); is_gemm = true; break;
        }
        const bool side_first = (k == 9) ? true : (((blockIdx.x >> 3) & 1) != 0);
#define SIDE_WORK() do { \
        if (k == 4) prep_weights(kp, lds, l, WM_A | WM_B | WM_O, 0, gridDim.x); \
        if (k == 6) prep_weights(kp, lds, l, WM_UP, 0, gridDim.x); \
        if (k == 9) { const int G = gridDim.x; prep_weights(kp, lds, l, WM_DN | WM_PG | WM_PLE, G / 2, G - G / 2); pb_convert(kp, l, G / 2, G - G / 2); } } while (0)
        if (side_first && (k == 4 || k == 6 || k == 9)) { SIDE_WORK(); asm volatile("s_waitcnt lgkmcnt(0)" ::: "memory"); __syncthreads(); }
        if (is_gemm) gemm_phase(lds, S, E);
        if (!side_first && (k == 4 || k == 6 || k == 9)) SIDE_WORK();
#undef SIDE_WORK
        if (ph + 1 < p.ph_hi && k != 3) { xcd_barrier(xbar); if (p.ph_lo < 0) grid.sync(); }
    }
}

extern "C" void kernel_launch(void* const* d_in, const int* in_sizes, int n_in, void* d_out, int out_size, void* d_ws, size_t ws_size, hipStream_t stream) {
    static int grid = 0;
    if (grid == 0) {
        if (n_in != 21 || out_size != M * D || ws_size < WS_END) { fprintf(stderr, "kernel_launch: unexpected problem (n_in %d out %d ws %zu)\n", n_in, out_size, ws_size); grid = -1; return; }
        int dev = 0, cus = 0, per_cu = 0;
        hipGetDevice(&dev); hipDeviceGetAttribute(&cus, hipDeviceAttributeMultiprocessorCount, dev);
        if (hipFuncSetAttribute((const void*)fwd_kernel, hipFuncAttributeMaxDynamicSharedMemorySize, LDS_BYTES) != hipSuccess) { fprintf(stderr, "kernel_launch: hipFuncSetAttribute failed\n"); grid = -1; return; }
        if (hipOccupancyMaxActiveBlocksPerMultiprocessor(&per_cu, (const void*)fwd_kernel, 512, LDS_BYTES) != hipSuccess || per_cu < 1) { fprintf(stderr, "kernel_launch: occupancy query %d\n", per_cu); per_cu = 1; }
        (void)hipGetLastError();
        grid = cus * (per_cu > 1 ? 1 : per_cu);
    }
    if (grid < 0) return;
    if (hipMemsetAsync((char*)d_ws + WS_CTL, 0, CTL_BYTES, stream) != hipSuccess) { fprintf(stderr, "kernel_launch: memset failed\n"); return; }
    Params p{};
    for (int i = 0; i < 21; ++i) p.in[i] = (const float*)d_in[i];
    p.out = (float*)d_out; p.ws = (unsigned char*)d_ws; p.ph_lo = 0; p.ph_hi = N_PHASES;
    void* args[] = {&p};
    hipError_t e = hipLaunchCooperativeKernel((const void*)fwd_kernel, dim3(grid), dim3(512), args, LDS_BYTES, stream);
    if (e != hipSuccess) fprintf(stderr, "cooperative launch failed: %s (grid %d)\n", hipGetErrorString(e), grid);
}
```

```cpp
#include <hip/hip_runtime.h>
#include <hip/hip_cooperative_groups.h>
#include <cstdio>
#include <cstdint>
namespace cg = cooperative_groups;

#define LAS __attribute__((address_space(3)))
typedef unsigned short bf16_t;
typedef short bf16x8 __attribute__((ext_vector_type(8)));
typedef float f32x4 __attribute__((ext_vector_type(4)));
typedef float f32x2 __attribute__((ext_vector_type(2)));
typedef unsigned u32x4 __attribute__((ext_vector_type(4)));
typedef unsigned u32x2 __attribute__((ext_vector_type(2)));

constexpr int M = 16384, SEQ = 8192, D = 1024, NIN = 5120, FF = 2816, NUP = 5632, PLE = 256;
constexpr float EPS = 1e-6f;
constexpr size_t MiB = 1u << 20;
constexpr size_t WS_SSQA = 0, WS_SSQB = 1 * MiB, WS_SSQV = 2 * MiB;
constexpr size_t WS_CTL = 3 * MiB, CTL_BYTES = 16384;
constexpr size_t WS_W = 4 * MiB;
constexpr size_t W_IN = WS_W, W_POOL = W_IN + (size_t)NIN * D * 2, W_A = W_POOL + (size_t)D * 256 * 2, W_B = W_A + (size_t)D * D * 2, W_O = W_B + (size_t)D * D * 2,
                 W_UP = W_O + (size_t)D * D * 2, W_DN = W_UP + (size_t)NUP * D * 2, W_PG = W_DN + (size_t)D * FF * 2, W_PLE = W_PG + (size_t)D * D * 2, W_S16 = W_PLE + (size_t)D * PLE * 2,
                 W_END = W_S16 + (size_t)8 * 128 * 128 * 2;
constexpr size_t WS_XB = 40 * MiB, WS_BIG = 72 * MiB, WS_END = 256 * MiB;
static_assert(W_END <= WS_XB, "weights fit");
constexpr size_t WS_Z = WS_BIG;
constexpr size_t WS_UPP = WS_BIG, WS_ACT = WS_BIG + 96 * MiB;
constexpr size_t WS_PB = WS_BIG, WS_C32 = WS_BIG + 8 * MiB;
__device__ __forceinline__ size_t ws_big(int l) { return (size_t)(l == 0 ? 72 : 40) * MiB; }
__device__ __forceinline__ size_t ws_xb(int l) { return (size_t)(l == 0 ? 40 : 224) * MiB; }
static_assert(WS_ACT + (size_t)M * FF * 2 <= WS_END && WS_Z + (size_t)M * NIN * 2 <= WS_END && WS_C32 + (size_t)M * D * 4 <= WS_ACT, "map");

constexpr int LDS_BYTES = 147456;

enum { MODE_IN = 0, MODE_POOL, MODE_YA, MODE_YB, MODE_RES, MODE_UP, MODE_E, MODE_PLE };

typedef __bf16 bf16x2_t __attribute__((ext_vector_type(2)));
__device__ __forceinline__ unsigned cvt_pk_bf16(float lo, float hi) { f32x2 v = {lo, hi}; bf16x2_t b = __builtin_convertvector(v, bf16x2_t); return __builtin_bit_cast(unsigned, b); }
__device__ __forceinline__ float bf_lo(unsigned w) { return __uint_as_float(w << 16); }
__device__ __forceinline__ float bf_hi(unsigned w) { return __uint_as_float(w & 0xffff0000u); }
__device__ __forceinline__ f32x2 gelu_pk(f32x2 v) {
    const f32x2 av = __builtin_elementwise_abs(v), d = av * 0.2316418882f + 1.0f;
    f32x2 t; t.x = __builtin_amdgcn_rcpf(d.x); t.y = __builtin_amdgcn_rcpf(d.y);
    f32x2 q = t * 0.5307027145f + (-0.7265760135f); q = q * t + 0.7107068705f; q = q * t + (-0.142248368f); q = q * t + 0.127414796f; q = q * t;
    const f32x2 s = (v * v) * (-0.72134752044f);
    f32x2 e; e.x = __builtin_amdgcn_exp2f(s.x); e.y = __builtin_amdgcn_exp2f(s.y);
    const f32x2 m = v * (q * e), r = v - m;
    f32x2 o; o.x = v.x < 0.f ? m.x : r.x; o.y = v.y < 0.f ? m.y : r.y; return o;
}
__device__ __forceinline__ float gelu1(float v) { f32x2 r = gelu_pk((f32x2){v, v}); return r.x; }
__device__ __forceinline__ float sigm(float v) { return __builtin_amdgcn_rcpf(1.0f + __builtin_amdgcn_exp2f(-1.44269504089f * v)); }
__device__ __forceinline__ float wave_sum(float v) {
#pragma unroll
    for (int o = 1; o < 64; o <<= 1) v += __shfl_xor(v, o);
    return v;
}

constexpr int BM = 256, BK = 64, HALF = 128, HTB = HALF * BK * 2;
__device__ __forceinline__ int lds_byte(int r, int c) { const int st = (r >> 4) * 2 + (c >> 5), rr = r & 15, cc = c & 31, ob = rr * 64 + cc * 2; return st * 1024 + (ob ^ (((ob >> 9) & 1) << 5)); }
__device__ __forceinline__ void stage_rc(int b, int& R, int& C) { const int st = b / 1024, sb = b % 1024, swz = sb ^ (((sb >> 9) & 1) << 5); R = (st >> 1) * 16 + swz / 64; C = (st & 1) * 32 + (swz % 64) / 2; }
__device__ __forceinline__ int perm32(int rho) { const int n = rho >> 4, i = rho & 15; return 8 * (i >> 2) + 4 * n + (i & 3); }

struct Unit { const char* a; const char* b; int lda, ldb, nt, mode, pm, pn; };
struct SubG { const bf16_t* A; const bf16_t* B; int lda, ldb, K, mode, a_pn, bsplit, bjump; };
struct Sched {
    SubG s0, s1; int nsub, nN, G, c;
    __device__ __forceinline__ bool next(int i, Unit& u) const {
        const int sub = (nsub == 2) ? (i & 1) : 0, ii = (nsub == 2) ? (i >> 1) : i;
        const int nwg = 64 * nN; const long L = (long)ii * G + c; if (L >= nwg) return false;
        int wgid = (int)L; wgid = (wgid % 8) * (nwg / 8) + wgid / 8;
        const int nig = 8 * nN, gid = wgid / nig; const int pm = gid * 8 + ((wgid % nig) % 8), pn = (wgid % nig) / 8;
        const bf16_t* A = sub ? s1.A : s0.A; const bf16_t* B = sub ? s1.B : s0.B;
        const int lda = sub ? s1.lda : s0.lda, ldb = sub ? s1.ldb : s0.ldb, K = sub ? s1.K : s0.K, mode = sub ? s1.mode : s0.mode, a_pn = sub ? s1.a_pn : s0.a_pn,
                  bsplit = sub ? s1.bsplit : s0.bsplit, bjump = sub ? s1.bjump : s0.bjump;
        const int bt = pn < bsplit ? pn : pn + bjump;
        u.a = (const char*)(A + (size_t)pm * 256 * lda + (size_t)pn * a_pn); u.b = (const char*)(B + (size_t)bt * 256 * ldb);
        u.lda = lda; u.ldb = ldb; u.nt = K / BK; u.mode = mode; u.pm = pm; u.pn = pn; return true;
    }
};

struct Epi {
    bf16_t* Z; bf16_t* out16; int ld16;
    const float* ssq_in; float* ssq_out; float* ssqv;
    const bf16_t* xin16; bf16_t* xout16;
    const float* pool_scale; bf16_t* C16;
};
#define EPI_FENCE asm volatile("" ::: "memory")
__device__ __forceinline__ u32x4 pack8(const f32x4& v0, const f32x4& v1) { u32x4 w; w.x = cvt_pk_bf16(v0[0], v0[1]); w.y = cvt_pk_bf16(v0[2], v0[3]); w.z = cvt_pk_bf16(v1[0], v1[1]); w.w = cvt_pk_bf16(v1[2], v1[3]); return w; }
__device__ __forceinline__ float sumsq8(const f32x4& v0, const f32x4& v1) { return (v0[0] * v0[0] + v0[1] * v0[1]) + (v0[2] * v0[2] + v0[3] * v0[3]) + (v1[0] * v1[0] + v1[1] * v1[1]) + (v1[2] * v1[2] + v1[3] * v1[3]); }
__device__ __forceinline__ void epi_rstd(const float* ssq, int row0, int fq, float (&rs)[2][4]) {
    float part[2][4][4];
#pragma unroll
    for (int ai = 0; ai < 2; ++ai)
#pragma unroll
        for (int m = 0; m < 4; ++m)
#pragma unroll
            for (int j = 0; j < 4; ++j) part[ai][m][j] = ssq[(size_t)(4 * fq + j) * M + row0 + ai * 128 + m * 16];
#pragma unroll
    for (int ai = 0; ai < 2; ++ai)
#pragma unroll
        for (int m = 0; m < 4; ++m) { float t = (part[ai][m][0] + part[ai][m][1]) + (part[ai][m][2] + part[ai][m][3]); t += __shfl_xor(t, 16); t += __shfl_xor(t, 32); rs[ai][m] = __builtin_amdgcn_rsqf(t * (1.0f / 1024.0f) + EPS); }
}
template <int ACT> __device__ __forceinline__ void epi_act_store(f32x4 (&acc)[2][2][4][2], const float (&rs)[2][4], bf16_t* out, int ld, int row0, int col0, float* ssqv_slot, bool want_ssq, int fq) {
#pragma unroll
    for (int ai = 0; ai < 2; ++ai)
#pragma unroll
        for (int m = 0; m < 4; ++m) { const int row = row0 + ai * 128 + m * 16; float sq = 0.f;
#pragma unroll
            for (int bj = 0; bj < 2; ++bj) { f32x4 v0 = acc[ai][bj][m][0] * rs[ai][m], v1 = acc[ai][bj][m][1] * rs[ai][m];
                if (ACT == 1) { f32x2 a = gelu_pk((f32x2){v0[0], v0[1]}), b = gelu_pk((f32x2){v0[2], v0[3]}), c = gelu_pk((f32x2){v1[0], v1[1]}), d = gelu_pk((f32x2){v1[2], v1[3]});
                    v0 = (f32x4){a.x, a.y, b.x, b.y}; v1 = (f32x4){c.x, c.y, d.x, d.y}; sq += sumsq8(v0, v1); }
                if (ACT == 2) {
#pragma unroll
                    for (int e = 0; e < 4; ++e) { v0[e] = sigm(v0[e]); v1[e] = sigm(v1[e]); } }
                *(u32x4*)(out + (size_t)row * ld + col0 + bj * 128) = pack8(v0, v1); }
            if (ACT == 1) { if (want_ssq) { sq += __shfl_xor(sq, 16); sq += __shfl_xor(sq, 32); if (fq == 0) ssqv_slot[row] = sq; } } }
}
__device__ __forceinline__ void epi_run(const Epi& E, f32x4 (&acc)[2][2][4][2], const Unit& u, int wr, int wc, int fr, int fq) {
    const int mode = u.mode;
    const int row0 = u.pm * 256 + wr * 64 + fr, col0 = u.pn * 256 + wc * 32 + 8 * fq;
    if (mode == MODE_IN || mode == MODE_UP) {
        float rs[2][4]; epi_rstd(E.ssq_in, row0, fq, rs);
        if (mode == MODE_UP) { epi_act_store<0>(acc, rs, E.out16, E.ld16, row0, col0, nullptr, false, fq); return; }
        const int atype = u.pn >> 2;
        if (atype == 2) epi_act_store<1>(acc, rs, E.Z, NIN, row0, col0, E.ssqv + (size_t)((u.pn - 8) * 4 + wc) * M, true, fq);
        else epi_act_store<0>(acc, rs, E.Z, NIN, row0, col0, nullptr, false, fq);
    } else if (mode == MODE_POOL) {
        f32x4 sc[2][2];
#pragma unroll
        for (int bj = 0; bj < 2; ++bj) { sc[bj][0] = *(const f32x4*)(E.pool_scale + col0 + bj * 128); sc[bj][1] = *(const f32x4*)(E.pool_scale + col0 + bj * 128 + 4); }
#pragma unroll
        for (int ai = 0; ai < 2; ++ai)
#pragma unroll
            for (int m = 0; m < 4; ++m)
#pragma unroll
                for (int bj = 0; bj < 2; ++bj) *(u32x4*)(E.Z + (size_t)(row0 + ai * 128 + m * 16) * NIN + col0 + bj * 128) = pack8(acc[ai][bj][m][0] * sc[bj][0], acc[ai][bj][m][1] * sc[bj][1]);
    } else if (mode == MODE_YA) {
        u32x4 g[2][4][2];
#pragma unroll
        for (int ai = 0; ai < 2; ++ai)
#pragma unroll
            for (int m = 0; m < 4; ++m)
#pragma unroll
                for (int bj = 0; bj < 2; ++bj) g[ai][m][bj] = *(const u32x4*)(E.Z + (size_t)(row0 + ai * 128 + m * 16) * NIN + 3072 + col0 + bj * 128);
#pragma unroll
        for (int ai = 0; ai < 2; ++ai)
#pragma unroll
            for (int m = 0; m < 4; ++m)
#pragma unroll
                for (int bj = 0; bj < 2; ++bj) { const f32x4 v0 = acc[ai][bj][m][0], v1 = acc[ai][bj][m][1]; const u32x4 gg = g[ai][m][bj]; u32x4 w;
                    w.x = cvt_pk_bf16(v0[0] * sigm(bf_lo(gg.x)), v0[1] * sigm(bf_hi(gg.x))); w.y = cvt_pk_bf16(v0[2] * sigm(bf_lo(gg.y)), v0[3] * sigm(bf_hi(gg.y)));
                    w.z = cvt_pk_bf16(v1[0] * sigm(bf_lo(gg.z)), v1[1] * sigm(bf_hi(gg.z))); w.w = cvt_pk_bf16(v1[2] * sigm(bf_lo(gg.w)), v1[3] * sigm(bf_hi(gg.w)));
                    *(u32x4*)(E.Z + (size_t)(row0 + ai * 128 + m * 16) * NIN + 3072 + col0 + bj * 128) = w; }
    } else if (mode == MODE_YB) {
#pragma unroll
        for (int ai = 0; ai < 2; ++ai) { u32x4 g[4][2], c[4][2];
#pragma unroll
            for (int m = 0; m < 4; ++m)
#pragma unroll
                for (int bj = 0; bj < 2; ++bj) { const bf16_t* gp = E.Z + (size_t)(row0 + ai * 128 + m * 16) * NIN + 4096 + col0 + bj * 128; g[m][bj] = *(const u32x4*)gp; c[m][bj] = *(const u32x4*)(gp - 1024); }
#pragma unroll
            for (int m = 0; m < 4; ++m)
#pragma unroll
                for (int bj = 0; bj < 2; ++bj) { const f32x4 v0 = acc[ai][bj][m][0], v1 = acc[ai][bj][m][1]; const u32x4 gg = g[m][bj], cc = c[m][bj]; u32x4 w;
                    w.x = cvt_pk_bf16(bf_lo(cc.x) + v0[0] * sigm(bf_lo(gg.x)), bf_hi(cc.x) + v0[1] * sigm(bf_hi(gg.x))); w.y = cvt_pk_bf16(bf_lo(cc.y) + v0[2] * sigm(bf_lo(gg.y)), bf_hi(cc.y) + v0[3] * sigm(bf_hi(gg.y)));
                    w.z = cvt_pk_bf16(bf_lo(cc.z) + v1[0] * sigm(bf_lo(gg.z)), bf_hi(cc.z) + v1[1] * sigm(bf_hi(gg.z))); w.w = cvt_pk_bf16(bf_lo(cc.w) + v1[2] * sigm(bf_lo(gg.w)), bf_hi(cc.w) + v1[3] * sigm(bf_hi(gg.w)));
                    *(u32x4*)(E.Z + (size_t)(row0 + ai * 128 + m * 16) * NIN + 4096 + col0 + bj * 128) = w; }
            EPI_FENCE; }
    } else if (mode == MODE_E) {
#pragma unroll
        for (int ai = 0; ai < 2; ++ai)
#pragma unroll
            for (int m = 0; m < 4; ++m)
#pragma unroll
                for (int bj = 0; bj < 2; ++bj) *(u32x4*)(E.C16 + (size_t)(row0 + ai * 128 + m * 16) * D + col0 + bj * 128) = pack8(acc[ai][bj][m][0], acc[ai][bj][m][1]);
    } else if (mode == MODE_RES) {
        float* sslot = E.ssq_out + (size_t)(u.pn * 4 + wc) * M;
        u32x4 x[2][4][2];
#pragma unroll
        for (int ai = 0; ai < 2; ++ai)
#pragma unroll
            for (int m = 0; m < 4; ++m)
#pragma unroll
                for (int bj = 0; bj < 2; ++bj) x[ai][m][bj] = *(const u32x4*)(E.xin16 + (size_t)(row0 + ai * 128 + m * 16) * D + col0 + bj * 128);
#pragma unroll
        for (int ai = 0; ai < 2; ++ai) {
#pragma unroll
            for (int m = 0; m < 4; ++m) { const int row = row0 + ai * 128 + m * 16; float sq = 0.f;
#pragma unroll
                for (int bj = 0; bj < 2; ++bj) { const u32x4 xx = x[ai][m][bj];
                    const f32x4 x0 = (f32x4){bf_lo(xx.x), bf_hi(xx.x), bf_lo(xx.y), bf_hi(xx.y)} + acc[ai][bj][m][0], x1 = (f32x4){bf_lo(xx.z), bf_hi(xx.z), bf_lo(xx.w), bf_hi(xx.w)} + acc[ai][bj][m][1];
                    sq += sumsq8(x0, x1); *(u32x4*)(E.xout16 + (size_t)row * D + col0 + bj * 128) = pack8(x0, x1); }
                sq += __shfl_xor(sq, 16); sq += __shfl_xor(sq, 32); if (fq == 0) sslot[row] = sq; }
            EPI_FENCE; }
    } else {
        float rs[2][4]; epi_rstd(E.ssq_in, row0, fq, rs);
        float* sslot = E.ssq_out + (size_t)(u.pn * 4 + wc) * M;
#pragma unroll
        for (int ai = 0; ai < 2; ++ai)
#pragma unroll
            for (int mh = 0; mh < 2; ++mh) { u32x4 x[2][2], c[2][2];
#pragma unroll
                for (int mm = 0; mm < 2; ++mm)
#pragma unroll
                    for (int bj = 0; bj < 2; ++bj) { const size_t off = (size_t)(row0 + ai * 128 + (2 * mh + mm) * 16) * D + col0 + bj * 128; x[mm][bj] = *(const u32x4*)(E.xin16 + off); c[mm][bj] = *(const u32x4*)(E.C16 + off); }
#pragma unroll
                for (int mm = 0; mm < 2; ++mm) { const int m = 2 * mh + mm, row = row0 + ai * 128 + m * 16; float sq = 0.f;
#pragma unroll
                    for (int bj = 0; bj < 2; ++bj) { const u32x4 xx = x[mm][bj], cc = c[mm][bj];
                        const f32x4 c0 = (f32x4){bf_lo(cc.x), bf_hi(cc.x), bf_lo(cc.y), bf_hi(cc.y)}, c1 = (f32x4){bf_lo(cc.z), bf_hi(cc.z), bf_lo(cc.w), bf_hi(cc.w)};
                        f32x4 v0 = acc[ai][bj][m][0] * rs[ai][m], v1 = acc[ai][bj][m][1] * rs[ai][m];
#pragma unroll
                        for (int e = 0; e < 4; ++e) { v0[e] = sigm(v0[e]) * c0[e]; v1[e] = sigm(v1[e]) * c1[e]; }
                        const f32x4 x0 = (f32x4){bf_lo(xx.x), bf_hi(xx.x), bf_lo(xx.y), bf_hi(xx.y)} + v0, x1 = (f32x4){bf_lo(xx.z), bf_hi(xx.z), bf_lo(xx.w), bf_hi(xx.w)} + v1;
                        sq += sumsq8(x0, x1); *(u32x4*)(E.xout16 + (size_t)row * D + col0 + bj * 128) = pack8(x0, x1); }
                    sq += __shfl_xor(sq, 16); sq += __shfl_xor(sq, 32); if (fq == 0) sslot[row] = sq; }
                }
    }
}

__device__ __forceinline__ void gemm_phase(LAS unsigned char* lds, const Sched& S, const Epi& E) {
    int tid_ = threadIdx.x; asm volatile("" : "+v"(tid_));
    const int tid = tid_, wid = __builtin_amdgcn_readfirstlane(tid >> 6), lane = tid & 63, wr = wid >> 2, wc = wid & 3, fr = lane & 15, fq = lane >> 4;
    int R0, C0, R1, C1; stage_rc(tid * 16, R0, C0); stage_rc(tid * 16 + 8192, R1, C1);
    const int Rb0 = (R0 & ~31) + perm32(R0 & 31), Rb1 = (R1 & ~31) + perm32(R1 & 31);
    const size_t kstep = (size_t)(BK * 2);
    const unsigned ldsw = (unsigned)wid * 1024u;
    const int aoff = lds_byte(wr * 64 + fr, fq * 8), boff = lds_byte(wc * 32 + fr, fq * 8);
#define PG8_SA(b, h) (((b) * 2 + (h)) * HTB)
#define PG8_SB(b, h) ((4 + (b) * 2 + (h)) * HTB)
#define PG8_STAGE(bufoff, gbase, v0, v1) do { \
        __builtin_amdgcn_global_load_lds((const unsigned*)((const char*)(gbase) + (v0)), (LAS unsigned*)(lds + (bufoff) + ldsw), 16, 0, 0); \
        __builtin_amdgcn_global_load_lds((const unsigned*)((const char*)(gbase) + (v1)), (LAS unsigned*)(lds + (bufoff) + ldsw + 8192), 16, 0, 0); } while (0)
#define PG8_LDA(dst, b, h) do { _Pragma("unroll") for (int m = 0; m < 4; ++m) _Pragma("unroll") for (int k = 0; k < 2; ++k) dst[m][k] = *(const LAS bf16x8*)(lds + PG8_SA(b, h) + aoff + m * 2048 + k * 1024); } while (0)
#define PG8_LDB(dst, b, h) do { _Pragma("unroll") for (int n = 0; n < 2; ++n) _Pragma("unroll") for (int k = 0; k < 2; ++k) dst[n][k] = *(const LAS bf16x8*)(lds + PG8_SB(b, h) + boff + n * 2048 + k * 1024); } while (0)
#define PG8_MMA(ai, bj, At, Bt) do { __builtin_amdgcn_s_setprio(1); _Pragma("unroll") for (int m = 0; m < 4; ++m) _Pragma("unroll") for (int n = 0; n < 2; ++n) _Pragma("unroll") for (int k = 0; k < 2; ++k) \
        acc[ai][bj][m][n] = __builtin_amdgcn_mfma_f32_16x16x32_bf16(Bt[n][k], At[m][k], acc[ai][bj][m][n], 0, 0, 0); __builtin_amdgcn_s_setprio(0); } while (0)
#define PG8_WAIT_V(n) asm volatile("s_waitcnt vmcnt(" #n ")" ::: "memory")
#define PG8_WAIT_L(n) asm volatile("s_waitcnt lgkmcnt(" #n ")" ::: "memory")
#define PG8_BAR __builtin_amdgcn_s_barrier()
#define PG8_SCHED __builtin_amdgcn_sched_barrier(0)
    Unit cur, nxt; int ui = 0;
    if (!S.next(0, cur)) return;
    f32x4 acc[2][2][4][2];
#pragma unroll
    for (int a = 0; a < 2; ++a)
#pragma unroll
        for (int b = 0; b < 2; ++b)
#pragma unroll
            for (int m = 0; m < 4; ++m)
#pragma unroll
                for (int n = 0; n < 2; ++n) acc[a][b][m][n] = (f32x4){0.f, 0.f, 0.f, 0.f};
    bf16x8 At[4][2], B0[2][2], B1[2][2];
    const char* cA = cur.a; const char* cB = cur.b;
    const unsigned RA0 = R0 * 2, RA1 = R1 * 2, RB0 = Rb0 * 2, RB1 = Rb1 * 2, CC0 = C0 * 2, CC1 = C1 * 2;
#define PG8_STA(bufoff, gbase, ld) PG8_STAGE(bufoff, gbase, RA0 * (unsigned)(ld) + CC0, RA1 * (unsigned)(ld) + CC1)
#define PG8_STB(bufoff, gbase, ld) PG8_STAGE(bufoff, gbase, RB0 * (unsigned)(ld) + CC0, RB1 * (unsigned)(ld) + CC1)
    int lda = cur.lda, ldb = cur.ldb;
    { const size_t hA = (size_t)HALF * lda * 2, hB = (size_t)HALF * ldb * 2;
    PG8_STB(PG8_SB(0, 0), cB, ldb); PG8_STB(PG8_SB(0, 1), cB + hB, ldb); PG8_STA(PG8_SA(0, 0), cA, lda); PG8_STA(PG8_SA(0, 1), cA + hA, lda);
    if (wr == 1) PG8_BAR;
    PG8_WAIT_V(2); PG8_BAR;
    PG8_STB(PG8_SB(1, 0), cB + kstep, ldb); PG8_STA(PG8_SA(1, 0), cA + kstep, lda); PG8_STB(PG8_SB(1, 1), cB + hB + kstep, ldb);
    PG8_WAIT_V(6); PG8_BAR; }
    for (;;) {
        const bool has_next = S.next(ui + 1, nxt);
        const char* nA = has_next ? nxt.a : cA; const char* nB = has_next ? nxt.b : cB;
        const int nlda = has_next ? nxt.lda : lda, nldb = has_next ? nxt.ldb : ldb;
        const size_t hA = (size_t)HALF * lda * 2;
        const int nt = cur.nt;
        const int nt_main = has_next ? nt : nt - 2;
        for (int t = 0; t < nt_main; t += 2) {
            const bool last = (t == nt - 2);
            const char* a1 = cA + (size_t)(t + 1) * kstep;
            const char* a2 = last ? nA : cA + (size_t)(t + 2) * kstep; const char* b2 = last ? nB : cB + (size_t)(t + 2) * kstep;
            const char* a3 = a2 + kstep; const char* b3 = b2 + kstep;
            const int xlda = last ? nlda : lda, xldb = last ? nldb : ldb;
            const size_t xhA = (size_t)HALF * xlda * 2, xhB = (size_t)HALF * xldb * 2;
            PG8_LDB(B0, 0, 0); PG8_LDB(B1, 0, 1); PG8_SCHED; PG8_LDA(At, 0, 0); PG8_STA(PG8_SA(1, 1), a1 + hA, lda);
            PG8_WAIT_V(8); PG8_WAIT_L(0); PG8_BAR; PG8_MMA(0, 0, At, B0); PG8_MMA(0, 1, At, B1); PG8_BAR; PG8_SCHED;
            PG8_LDA(At, 0, 1); PG8_STB(PG8_SB(0, 0), b2, xldb); PG8_STB(PG8_SB(0, 1), b2 + xhB, xldb); PG8_STA(PG8_SA(0, 0), a2, xlda);
            PG8_WAIT_V(8); PG8_WAIT_L(0); PG8_BAR; PG8_MMA(1, 0, At, B0); PG8_MMA(1, 1, At, B1); PG8_BAR; PG8_SCHED;
            PG8_LDB(B0, 1, 0); PG8_LDB(B1, 1, 1); PG8_SCHED; PG8_LDA(At, 1, 0); PG8_STA(PG8_SA(0, 1), a2 + xhA, xlda);
            PG8_WAIT_V(8); PG8_WAIT_L(0); PG8_BAR; PG8_MMA(0, 0, At, B0); PG8_MMA(0, 1, At, B1); PG8_BAR; PG8_SCHED;
            PG8_LDA(At, 1, 1); PG8_STB(PG8_SB(1, 0), b3, xldb); PG8_STB(PG8_SB(1, 1), b3 + xhB, xldb); PG8_STA(PG8_SA(1, 0), a3, xlda);
            PG8_WAIT_V(8); PG8_WAIT_L(0); PG8_BAR; PG8_MMA(1, 0, At, B0); PG8_MMA(1, 1, At, B1); PG8_BAR; PG8_SCHED;
        }
        if (!has_next) {
            const char* a1 = cA + (size_t)(nt - 1) * kstep;
            PG8_LDB(B0, 0, 0); PG8_LDB(B1, 0, 1); PG8_SCHED; PG8_LDA(At, 0, 0); PG8_STA(PG8_SA(1, 1), a1 + hA, lda);
            PG8_WAIT_V(8); PG8_WAIT_L(0); PG8_BAR; PG8_MMA(0, 0, At, B0); PG8_MMA(0, 1, At, B1); PG8_BAR; PG8_SCHED;
            PG8_LDA(At, 0, 1);
            PG8_WAIT_V(2); PG8_WAIT_L(0); PG8_BAR; PG8_MMA(1, 0, At, B0); PG8_MMA(1, 1, At, B1); PG8_BAR; PG8_SCHED;
            PG8_LDB(B0, 1, 0); PG8_LDB(B1, 1, 1); PG8_SCHED; PG8_LDA(At, 1, 0);
            PG8_WAIT_V(0); PG8_WAIT_L(0); PG8_BAR; PG8_MMA(0, 0, At, B0); PG8_MMA(0, 1, At, B1); PG8_BAR; PG8_SCHED;
            PG8_LDA(At, 1, 1);
            PG8_WAIT_L(0); PG8_BAR; PG8_MMA(1, 0, At, B0); PG8_MMA(1, 1, At, B1); PG8_BAR; PG8_SCHED;
        }
        if (wr == 0) PG8_BAR;
        epi_run(E, acc, cur, wr, wc, fr, fq);
        if (!has_next) break;
#pragma unroll
        for (int a = 0; a < 2; ++a)
#pragma unroll
            for (int b = 0; b < 2; ++b)
#pragma unroll
                for (int m = 0; m < 4; ++m)
#pragma unroll
                    for (int n = 0; n < 2; ++n) acc[a][b][m][n] = (f32x4){0.f, 0.f, 0.f, 0.f};
        cur = nxt; cA = nA; cB = nB; lda = nlda; ldb = nldb; ++ui;
        if (wr == 1) PG8_BAR;
    }
#undef PG8_STA
#undef PG8_STB
    PG8_WAIT_V(0);
    PG8_BAR;
#undef PG8_SA
#undef PG8_SB
#undef PG8_STAGE
#undef PG8_LDA
#undef PG8_LDB
#undef PG8_MMA
#undef PG8_WAIT_V
#undef PG8_WAIT_L
#undef PG8_BAR
#undef PG8_SCHED
}

struct Params { const float* in[21]; float* out; unsigned char* ws; int ph_lo, ph_hi; };
typedef const __attribute__((address_space(4))) Params* KP;
__device__ __forceinline__ KP kparams() { KP k = (KP)__builtin_amdgcn_kernarg_segment_ptr(); asm volatile("" : "+s"(k)); return k; }
enum { I_X = 0, I_P, I_MIXN, I_WIN, I_WPOOL, I_PSCALE, I_SGUN, I_WSP, I_BSP, I_WA, I_WB, I_WO, I_FFNN, I_WUP, I_CONVW, I_CONVB, I_WDN, I_PLEN, I_WPG, I_WPLE, I_FINN };

__device__ __forceinline__ void transpose_item(const float* W, const float* gain, int K, int N, bf16_t* WT, int row_off, LAS float* scr, int item, int lane) {
    const int nblk = N / 32, kb = item / nblk, nb = item % nblk, k0 = 64 * kb, n0 = 32 * nb;
    float tv[32];
#pragma unroll
    for (int i = 0; i < 32; ++i) { const int kk = 2 * i + (lane >> 5); tv[i] = W[(size_t)(k0 + kk) * N + n0 + (lane & 31)]; }
    if (gain) {
#pragma unroll
        for (int i = 0; i < 32; ++i) tv[i] *= gain[k0 + 2 * i + (lane >> 5)]; }
#pragma unroll
    for (int i = 0; i < 32; ++i) scr[(2 * i + (lane >> 5)) * 33 + (lane & 31)] = tv[i];
    asm volatile("s_waitcnt lgkmcnt(0)" ::: "memory");
    const int c = lane & 7;
#pragma unroll
    for (int j = 0; j < 4; ++j) { const int n = (lane >> 3) + 8 * j; const LAS float* s = scr + (8 * c) * 33 + n;
        u32x4 o; o.x = cvt_pk_bf16(s[0 * 33], s[1 * 33]); o.y = cvt_pk_bf16(s[2 * 33], s[3 * 33]); o.z = cvt_pk_bf16(s[4 * 33], s[5 * 33]); o.w = cvt_pk_bf16(s[6 * 33], s[7 * 33]);
        *(u32x4*)(WT + (size_t)(row_off + n0 + n) * K + k0 + 8 * c) = o; }
    asm volatile("s_waitcnt lgkmcnt(0)" ::: "memory");
}

enum { WM_IN = 1, WM_POOL = 2, WM_A = 4, WM_B = 8, WM_O = 16, WM_UP = 32, WM_DN = 64, WM_PG = 128, WM_PLE = 256 };
__device__ __forceinline__ void prep_weights(KP kp, LAS unsigned char* lds, int l, int mask, int first_wg, int n_wg) {
    unsigned char* ws = kp->ws;
    int tid_ = threadIdx.x; asm volatile("" : "+v"(tid_));
    const int lane = tid_ & 63, wave = tid_ >> 6;
    if ((int)blockIdx.x < first_wg) return;
    LAS float* scr = (LAS float*)(lds + wave * 16384);
    const int gw = ((int)blockIdx.x - first_wg) * 8 + wave, NGW = n_wg * 8;
    constexpr int I_IN = (D / 64) * (NIN / 32), I_PL = (256 / 64) * (256 / 32), I_SQ = (D / 64) * (D / 32), I_UP = (D / 64) * (NUP / 32), I_DN = (FF / 64) * (D / 32), I_PE = (PLE / 64) * (D / 32);
    const int n_in = (mask & WM_IN) ? I_IN : 0, n_pl = (mask & WM_POOL) ? 4 * I_PL : 0, n_a = (mask & WM_A) ? I_SQ : 0, n_b = (mask & WM_B) ? I_SQ : 0, n_o = (mask & WM_O) ? I_SQ : 0,
              n_up = (mask & WM_UP) ? I_UP : 0, n_dn = (mask & WM_DN) ? I_DN : 0, n_pg = (mask & WM_PG) ? I_SQ : 0, n_pe = (mask & WM_PLE) ? I_PE : 0;
    const int nitems = n_in + n_pl + n_a + n_b + n_o + n_up + n_dn + n_pg + n_pe;
    for (int it = gw; it < nitems; it += NGW) {
        int r = it;
        if (r < n_in) { transpose_item(kp->in[I_WIN] + (size_t)l * D * NIN, kp->in[I_MIXN] + l * D, D, NIN, (bf16_t*)(ws + W_IN), 0, scr, r, lane); continue; } r -= n_in;
        if (r < n_pl) { const int g = r / I_PL; transpose_item(kp->in[I_WPOOL] + ((size_t)l * 4 + g) * 256 * 256, nullptr, 256, 256, (bf16_t*)(ws + W_POOL), g * 256, scr, r % I_PL, lane); continue; } r -= n_pl;
        if (r < n_a) { transpose_item(kp->in[I_WA] + (size_t)l * D * D, nullptr, D, D, (bf16_t*)(ws + W_A), 0, scr, r, lane); continue; } r -= n_a;
        if (r < n_b) { transpose_item(kp->in[I_WB] + (size_t)l * D * D, nullptr, D, D, (bf16_t*)(ws + W_B), 0, scr, r, lane); continue; } r -= n_b;
        if (r < n_o) { transpose_item(kp->in[I_WO] + (size_t)l * D * D, nullptr, D, D, (bf16_t*)(ws + W_O), 0, scr, r, lane); continue; } r -= n_o;
        if (r < n_up) { transpose_item(kp->in[I_WUP] + (size_t)l * D * NUP, kp->in[I_FFNN] + l * D, D, NUP, (bf16_t*)(ws + W_UP), 0, scr, r, lane); continue; } r -= n_up;
        if (r < n_dn) { transpose_item(kp->in[I_WDN] + (size_t)l * FF * D, nullptr, FF, D, (bf16_t*)(ws + W_DN), 0, scr, r, lane); continue; } r -= n_dn;
        if (r < n_pg) { transpose_item(kp->in[I_WPG] + (size_t)l * D * D, kp->in[I_PLEN] + l * D, D, D, (bf16_t*)(ws + W_PG), 0, scr, r, lane); continue; } r -= n_pg;
        transpose_item(kp->in[I_WPLE] + (size_t)l * PLE * D, nullptr, PLE, D, (bf16_t*)(ws + W_PLE), 0, scr, r, lane);
    }
}
__device__ __forceinline__ void prep_phase(KP kp, LAS unsigned char* lds, int l) {
    unsigned char* ws = kp->ws;
    prep_weights(kp, lds, l, WM_IN | WM_POOL, 0, gridDim.x);
    int tid_ = threadIdx.x; asm volatile("" : "+v"(tid_));
    const int tid = tid_, lane = tid & 63, wave = tid >> 6;
    const int gw = blockIdx.x * 8 + wave, NGW = gridDim.x * 8;
    { const float* wsp = kp->in[I_WSP] + (size_t)l * 8 * 128 * 128; bf16_t* o = (bf16_t*)(ws + W_S16);
      for (int i = blockIdx.x * 512 + tid; i < 8 * 128 * 128 / 2; i += gridDim.x * 512) { const int e = 2 * i, s = e & 127, t = (e >> 7) & 127;
          const f32x2 v = *(const f32x2*)(wsp + e); *(unsigned*)(o + e) = cvt_pk_bf16(s <= t ? v.x : 0.f, (s + 1) <= t ? v.y : 0.f); } }
    const float* xsrc = kp->in[I_X]; bf16_t* XB = (bf16_t*)(ws + ws_xb(0)); float* ssqa = (float*)(ws + WS_SSQA);
    if (l == 0) for (int m = gw; m < M; m += 4 * NGW) {
        f32x4 v[4][4];
#pragma unroll
        for (int r = 0; r < 4; ++r) { const int mm = m + r * NGW; if (mm < M) { const f32x4* xr = (const f32x4*)(xsrc + (size_t)mm * D) + lane;
#pragma unroll
            for (int j = 0; j < 4; ++j) v[r][j] = xr[64 * j]; } }
#pragma unroll
        for (int r = 0; r < 4; ++r) { const int mm = m + r * NGW; if (mm < M) { float sacc = 0.f;
#pragma unroll
            for (int j = 0; j < 4; ++j) sacc += (v[r][j].x * v[r][j].x + v[r][j].y * v[r][j].y) + (v[r][j].z * v[r][j].z + v[r][j].w * v[r][j].w);
            u32x2* o8 = (u32x2*)(XB + (size_t)mm * D) + lane;
#pragma unroll
            for (int j = 0; j < 4; ++j) { u32x2 w; w.x = cvt_pk_bf16(v[r][j].x, v[r][j].y); w.y = cvt_pk_bf16(v[r][j].z, v[r][j].w); o8[64 * j] = w; }
            const float tot = wave_sum(sacc); if (lane < 16) ssqa[(size_t)lane * M + mm] = (lane == 0) ? tot : 0.f; } }
    }
}

__device__ __forceinline__ void unpack8(const u32x4& r, float (&v)[8]) { v[0] = bf_lo(r.x); v[1] = bf_hi(r.x); v[2] = bf_lo(r.y); v[3] = bf_hi(r.y); v[4] = bf_lo(r.z); v[5] = bf_hi(r.z); v[6] = bf_lo(r.w); v[7] = bf_hi(r.w); }
__device__ __forceinline__ void sgu_phase(KP kp, LAS unsigned char* lds, int l) {
    unsigned char* ws = kp->ws; bf16_t* Z = (bf16_t*)(ws + ws_big(l)); const float* ssqv = (const float*)(ws + WS_SSQV); const bf16_t* ws16 = (const bf16_t*)(ws + W_S16);
    const float* bsp = kp->in[I_BSP] + l * 8 * 128; const float* gn = kp->in[I_SGUN] + l * D;
    int tid_ = threadIdx.x; asm volatile("" : "+v"(tid_));
    const int tid = tid_, wid = tid >> 6, lane = tid & 63, fr = lane & 15, fq = lane >> 4;
    LAS float* rsd = (LAS float*)(lds + 40960);
    const bool local_map = (gridDim.x == 256);
    int pm_ = 0, pn_ = 0;
    { const int c = blockIdx.x, wgid = (c % 8) * 32 + c / 8; pm_ = (wgid / 32) * 8 + ((wgid % 32) % 8); pn_ = (wgid % 32) / 8; }
    const int n_units = local_map ? 4 : (1024 - (int)blockIdx.x + (int)gridDim.x - 1) / (int)gridDim.x;
    for (int ui = 0; ui < n_units; ++ui) {
        const int u = local_map ? ((2 * pm_ + (ui >> 1)) * 8 + 2 * pn_ + (ui & 1)) : ((int)blockIdx.x + ui * (int)gridDim.x);
        const int h = u & 7, r0 = (u >> 3) * 128;
        if (tid < 128) { float s = 0.f;
#pragma unroll
            for (int j = 0; j < 16; ++j) s += ssqv[(size_t)j * M + r0 + tid];
            rsd[tid] = __builtin_amdgcn_rsqf(s * (1.0f / 1024.0f) + EPS); }
        __syncthreads();
        { const int dc = tid & 15; const f32x4 g0 = *(const f32x4*)(gn + h * 128 + dc * 8), g1 = *(const f32x4*)(gn + h * 128 + dc * 8 + 4);
#pragma unroll
          for (int j = 0; j < 4; ++j) { const int s = (tid >> 4) + 32 * j; const u32x4 raw = *(const u32x4*)(Z + (size_t)(r0 + s) * NIN + 2048 + h * 128 + dc * 8); const float r = rsd[s];
              u32x4 wv; wv.x = cvt_pk_bf16(bf_lo(raw.x) * r * g0.x, bf_hi(raw.x) * r * g0.y); wv.y = cvt_pk_bf16(bf_lo(raw.y) * r * g0.z, bf_hi(raw.y) * r * g0.w);
              wv.z = cvt_pk_bf16(bf_lo(raw.z) * r * g1.x, bf_hi(raw.z) * r * g1.y); wv.w = cvt_pk_bf16(bf_lo(raw.w) * r * g1.z, bf_hi(raw.w) * r * g1.w);
              *(LAS u32x4*)(lds + 256 * s + 16 * (dc ^ (((s & 3) << 2) | ((s >> 2) & 3)))) = wv; } }
        __syncthreads();
        const int kkmax = (16 * wid + 15) >> 5;
        bf16x8 wfa[4];
#pragma unroll
        for (int kk = 0; kk < 4; ++kk) wfa[kk] = (kk <= kkmax) ? *(const bf16x8*)(ws16 + (size_t)(h * 128 + 16 * wid + fr) * 128 + 32 * kk + 8 * fq) : (bf16x8){0, 0, 0, 0, 0, 0, 0, 0};
        const int t = 16 * wid + fr; const float bias = bsp[h * 128 + t]; bf16_t* up = Z + (size_t)(r0 + t) * NIN + 1024 + h * 128 + 4 * fq;
        u32x2 uu[8];
#pragma unroll
        for (int n = 0; n < 8; ++n) uu[n] = *(const u32x2*)(up + 16 * n);
        { const int w = 2 << (h >> 1), pc = tid & 15, pr = (tid >> 4) * 4, t0 = (r0 + pr) & (SEQ - 1);
          const bf16_t* src = Z + (size_t)(r0 + pr) * NIN + h * 128 + pc * 8;
          float ps[8];
#pragma unroll
          for (int e = 0; e < 8; ++e) ps[e] = 0.f;
          { u32x4 hw[15];
#pragma unroll
            for (int j = 1; j < 16; ++j) hw[j - 1] = (j < w && t0 - j >= 0) ? *(const u32x4*)(src - (size_t)j * NIN) : (u32x4){0u, 0u, 0u, 0u};
#pragma unroll
            for (int j = 0; j < 15; ++j) { float v[8]; unpack8(hw[j], v);
#pragma unroll
                for (int e = 0; e < 8; ++e) ps[e] += v[e]; } }
          u32x4 cu[4], ol[4];
#pragma unroll
          for (int i = 0; i < 4; ++i) { cu[i] = *(const u32x4*)(src + (size_t)i * NIN);
              ol[i] = (t0 + i - w + 1 >= 0) ? *(const u32x4*)(src + (ptrdiff_t)(i - w + 1) * NIN) : (u32x4){0u, 0u, 0u, 0u}; }
#pragma unroll
          for (int i = 0; i < 4; ++i) {
              float cur[8]; unpack8(cu[i], cur);
              const int t = t0 + i, n = (t + 1 < w) ? t + 1 : w; const float inv = 1.0f / (float)n;
              float o[8];
#pragma unroll
              for (int e = 0; e < 8; ++e) { ps[e] += cur[e]; o[e] = ps[e] * inv - cur[e]; }
              u32x4 ov; ov.x = cvt_pk_bf16(o[0], o[1]); ov.y = cvt_pk_bf16(o[2], o[3]); ov.z = cvt_pk_bf16(o[4], o[5]); ov.w = cvt_pk_bf16(o[6], o[7]);
              *(u32x4*)(Z + (size_t)(r0 + pr + i) * NIN + 2048 + h * 128 + pc * 8) = ov;
              { float old[8]; unpack8(ol[i], old);
#pragma unroll
                for (int e = 0; e < 8; ++e) ps[e] -= old[e]; }
          } }
        f32x4 acc[8];
#pragma unroll
        for (int n = 0; n < 8; ++n) acc[n] = (f32x4){0.f, 0.f, 0.f, 0.f};
#pragma unroll
        for (int kk = 0; kk < 4; ++kk) {
            if (kk <= kkmax) {
#pragma unroll
                for (int n = 0; n < 8; ++n) {
                    const int q_ = fr >> 2, p_ = fr & 3, rowb = 32 * kk + 8 * fq + q_, chb = 2 * n + (p_ >> 1);
                    const int a0 = 256 * rowb + 16 * (chb ^ ((q_ << 2) | ((2 * fq) & 3))) + 8 * (p_ & 1), a1 = 256 * (rowb + 4) + 16 * (chb ^ ((q_ << 2) | ((2 * fq + 1) & 3))) + 8 * (p_ & 1);
                    typedef short s16x4_t __attribute__((ext_vector_type(4)));
                    const s16x4_t lo = __builtin_amdgcn_ds_read_tr16_b64_v4i16((LAS s16x4_t*)(lds + a0)), hi = __builtin_amdgcn_ds_read_tr16_b64_v4i16((LAS s16x4_t*)(lds + a1));
                    const bf16x8 vf = (bf16x8){lo[0], lo[1], lo[2], lo[3], hi[0], hi[1], hi[2], hi[3]};
                    acc[n] = __builtin_amdgcn_mfma_f32_16x16x32_bf16(vf, wfa[kk], acc[n], 0, 0, 0); }
            }
        }
#pragma unroll
        for (int n = 0; n < 8; ++n) { u32x2 w;
            const f32x2 ua = gelu_pk((f32x2){bf_lo(uu[n].x), bf_hi(uu[n].x)}), ub = gelu_pk((f32x2){bf_lo(uu[n].y), bf_hi(uu[n].y)});
            w.x = cvt_pk_bf16(ua.x * (acc[n][0] + bias), ua.y * (acc[n][1] + bias)); w.y = cvt_pk_bf16(ub.x * (acc[n][2] + bias), ub.y * (acc[n][3] + bias));
            *(u32x2*)(up + 16 * n) = w; }
        __syncthreads();
    }
}

__device__ __forceinline__ void conv_phase(KP kp, int l, int a0t, int na) {
    const bf16_t* UPP = (const bf16_t*)(kp->ws + ws_big(l)); bf16_t* ACT = (bf16_t*)(kp->ws + ws_big(l) + 96 * MiB);
    const float* cw = kp->in[I_CONVW] + (size_t)l * 3 * NUP; const float* cb = kp->in[I_CONVB] + (size_t)l * NUP;
    const int nchunk = na * 32, ldu = 2 * na * 256, total = (M / 8) * nchunk, NT = gridDim.x * 512;
    int tid_ = threadIdx.x; asm volatile("" : "+v"(tid_));
    for (int idx = blockIdx.x * 512 + tid_; idx < total; idx += NT) {
        const int chunk = idx % nchunk, row0 = (idx / nchunk) * 8, t0 = row0 & (SEQ - 1), ca = chunk * 8, j = a0t * 256 + ca;
        float wa[3][8], wb[3][8], ba[8], bb[8];
#pragma unroll
        for (int k = 0; k < 3; ++k) { const float* wk = cw + (size_t)k * NUP + j; const f32x4 a0 = *(const f32x4*)wk, a1 = *(const f32x4*)(wk + 4), b0 = *(const f32x4*)(wk + FF), b1 = *(const f32x4*)(wk + FF + 4);
#pragma unroll
            for (int e = 0; e < 4; ++e) { wa[k][e] = a0[e]; wa[k][4 + e] = a1[e]; wb[k][e] = b0[e]; wb[k][4 + e] = b1[e]; } }
        { const f32x4 a0 = *(const f32x4*)(cb + j), a1 = *(const f32x4*)(cb + j + 4), b0 = *(const f32x4*)(cb + FF + j), b1 = *(const f32x4*)(cb + FF + j + 4);
#pragma unroll
          for (int e = 0; e < 4; ++e) { ba[e] = a0[e]; ba[4 + e] = a1[e]; bb[e] = b0[e]; bb[4 + e] = b1[e]; } }
        const bf16_t* src = UPP + (size_t)row0 * ldu + ca;
        u32x4 ra[10], rb[10];
#pragma unroll
        for (int i = 0; i < 10; ++i) { if (i >= 2 || t0 > 0) { ra[i] = *(const u32x4*)(src + (ptrdiff_t)(i - 2) * ldu); rb[i] = *(const u32x4*)(src + (ptrdiff_t)(i - 2) * ldu + na * 256); }
                                       else { ra[i] = (u32x4){0u, 0u, 0u, 0u}; rb[i] = (u32x4){0u, 0u, 0u, 0u}; } }
#pragma unroll
        for (int i = 0; i < 8; ++i) {
            float va[8], vb[8];
#pragma unroll
            for (int e = 0; e < 8; ++e) { va[e] = ba[e]; vb[e] = bb[e]; }
#pragma unroll
            for (int k = 0; k < 3; ++k) { float xa[8], xb[8]; unpack8(ra[i + k], xa); unpack8(rb[i + k], xb);
#pragma unroll
                for (int e = 0; e < 8; ++e) { va[e] += wa[k][e] * xa[e]; vb[e] += wb[k][e] * xb[e]; } }
            u32x4 o; { f32x2 gg;
                gg = gelu_pk((f32x2){va[0], va[1]}); o.x = cvt_pk_bf16(gg.x * vb[0], gg.y * vb[1]); gg = gelu_pk((f32x2){va[2], va[3]}); o.y = cvt_pk_bf16(gg.x * vb[2], gg.y * vb[3]);
                gg = gelu_pk((f32x2){va[4], va[5]}); o.z = cvt_pk_bf16(gg.x * vb[4], gg.y * vb[5]); gg = gelu_pk((f32x2){va[6], va[7]}); o.w = cvt_pk_bf16(gg.x * vb[6], gg.y * vb[7]); }
            *(u32x4*)(ACT + (size_t)(row0 + i) * FF + j) = o;
        }
    }
}

__device__ __forceinline__ void pb_convert(KP kp, int l, int first_wg, int n_wg) {
    const float* src = kp->in[I_P] + (size_t)l * M * PLE; bf16_t* PB = (bf16_t*)(kp->ws + ws_big(l) + 80 * MiB);
    const int NT = n_wg * 512;
    int tid_ = threadIdx.x; asm volatile("" : "+v"(tid_));
    if ((int)blockIdx.x < first_wg) return;
    for (int idx = ((int)blockIdx.x - first_wg) * 512 + tid_; idx < M * PLE / 8; idx += NT) {
        const f32x4 a = *(const f32x4*)(src + (size_t)idx * 8), b = *(const f32x4*)(src + (size_t)idx * 8 + 4);
        u32x4 o; o.x = cvt_pk_bf16(a.x, a.y); o.y = cvt_pk_bf16(a.z, a.w); o.z = cvt_pk_bf16(b.x, b.y); o.w = cvt_pk_bf16(b.z, b.w);
        *(u32x4*)(PB + (size_t)idx * 8) = o;
    }
}

__device__ __forceinline__ void final_phase(KP kp, const float* ssq, const bf16_t* XF) {
    int tid_ = threadIdx.x; asm volatile("" : "+v"(tid_));
    const int tid = tid_, lane = tid & 63, wave = tid >> 6, gw = blockIdx.x * 8 + wave, NGW = gridDim.x * 8;
    const float* g = kp->in[I_FINN];
    f32x4 gv[2][2];
#pragma unroll
    for (int j = 0; j < 2; ++j) { gv[j][0] = *(const f32x4*)(g + (lane + 64 * j) * 8); gv[j][1] = *(const f32x4*)(g + (lane + 64 * j) * 8 + 4); }
    for (int m = gw; m < M; m += 2 * NGW) {
        const int m1 = m + NGW;
        const float p0 = (lane < 16) ? ssq[(size_t)lane * M + m] : 0.f, p1 = (lane < 16) ? ssq[(size_t)lane * M + m1] : 0.f;
        u32x4 v[2][2];
#pragma unroll
        for (int j = 0; j < 2; ++j) { v[0][j] = *((const u32x4*)(XF + (size_t)m * D) + lane + 64 * j); v[1][j] = *((const u32x4*)(XF + (size_t)m1 * D) + lane + 64 * j); }
        const float rs0 = __builtin_amdgcn_rsqf(wave_sum(p0) * (1.0f / 1024.0f) + EPS), rs1 = __builtin_amdgcn_rsqf(wave_sum(p1) * (1.0f / 1024.0f) + EPS);
#pragma unroll
        for (int r = 0; r < 2; ++r) { const float rs = r ? rs1 : rs0; float* orow = kp->out + (size_t)(r ? m1 : m) * D;
#pragma unroll
            for (int j = 0; j < 2; ++j) { const u32x4 xx = v[r][j];
                *(f32x4*)(orow + (lane + 64 * j) * 8) = (f32x4){bf_lo(xx.x), bf_hi(xx.x), bf_lo(xx.y), bf_hi(xx.y)} * rs * gv[j][0];
                *(f32x4*)(orow + (lane + 64 * j) * 8 + 4) = (f32x4){bf_lo(xx.z), bf_hi(xx.z), bf_lo(xx.w), bf_hi(xx.w)} * rs * gv[j][1]; } }
    }
}

#define XB_TMO      128
#define XB_XCNT(j)  (256  + 64 * (j))
#define XB_XSUB(j)  (1280 + 64 * (j))
#define XB_XGEN(j)  (2304 + 64 * (j))
#define XB_TOP      3328
#define XB_TOPGEN   3392
#define XCD_BAR_WORDS 3456
#define XB_SPIN_CAP (1u << 18)

__device__ __forceinline__ unsigned xb_ld(unsigned* p)              { return __hip_atomic_load(p, __ATOMIC_RELAXED, __HIP_MEMORY_SCOPE_AGENT); }
__device__ __forceinline__ unsigned xb_add(unsigned* p, unsigned v) { return __hip_atomic_fetch_add(p, v, __ATOMIC_RELAXED, __HIP_MEMORY_SCOPE_AGENT); }
__device__ __forceinline__ unsigned xb_xcc_id() { return (unsigned)__builtin_amdgcn_s_getreg((3 << 11) | 20) & 0xFu; }
#define XB_SPIN(cond, bar) do { unsigned _sp = 0; while (cond) { __builtin_amdgcn_s_sleep(1); \
    if ((++_sp & 255u) == 0u) { if (xb_ld(&(bar)[XB_TMO])) break; if (_sp > XB_SPIN_CAP) { atomicAdd(&(bar)[XB_TMO], 1u); break; } } } } while (0)

struct XcdBarrier {
    unsigned* bar; unsigned x;
    volatile LAS unsigned* st;
};

__device__ __forceinline__ XcdBarrier xcd_barrier_post(unsigned* bar, volatile LAS unsigned* st) {
    XcdBarrier b; b.bar = bar; b.x = xb_xcc_id(); b.st = st;
    if (threadIdx.x == 0) (void)xb_add(&bar[XB_XCNT(b.x)], 1u);
    return b;
}
__device__ __forceinline__ void xcd_barrier_complete(unsigned* bar, unsigned x, unsigned& nloc, unsigned& nx) {
    const unsigned G = gridDim.x * gridDim.y * gridDim.z;
    unsigned sum, cnt, mine, sp = 0u;
    for (;;) {
        sum = 0u; cnt = 0u; mine = 0u;
#pragma unroll
        for (unsigned j = 0; j < 16; ++j) { const unsigned c = xb_ld(&bar[XB_XCNT(j)]); sum += c; cnt += (c > 0u) ? 1u : 0u; mine = (j == x) ? c : mine; }
        if (sum == G) break;
        __builtin_amdgcn_s_sleep(1);
        if ((++sp & 255u) == 0u) { if (xb_ld(&bar[XB_TMO])) break; if (sp > XB_SPIN_CAP) { atomicAdd(&bar[XB_TMO], 1u); break; } }
    }
    nloc = mine > 0u ? mine : 1u; nx = cnt > 0u ? cnt : 1u;
}

__device__ __forceinline__ void xcd_barrier(const XcdBarrier& b) {
    asm volatile("s_waitcnt vmcnt(0)" ::: "memory");
    __syncthreads();
    if (threadIdx.x == 0) {
        unsigned* bar = b.bar;
        __builtin_amdgcn_s_waitcnt(0);
        unsigned nloc = b.st[0], nx = b.st[1];
        if (nloc == 0u) { xcd_barrier_complete(bar, b.x, nloc, nx); b.st[0] = nloc; b.st[1] = nx; }
        const unsigned old = xb_add(&bar[XB_XSUB(b.x)], 1u);
        const unsigned gen = old / nloc;
        if (old + 1u == (gen + 1u) * nloc) {
            __builtin_amdgcn_fence(__ATOMIC_RELEASE, "agent");
            asm volatile("s_waitcnt vmcnt(0)" ::: "memory");
            const unsigned og = xb_add(&bar[XB_TOP], 1u);
            const unsigned tg = og / nx;
            __builtin_amdgcn_fence(__ATOMIC_ACQUIRE, "agent");
            if (og + 1u == (tg + 1u) * nx) xb_add(&bar[XB_TOPGEN], 1u);
            else XB_SPIN(xb_ld(&bar[XB_TOPGEN]) == tg, bar);
            xb_add(&bar[XB_XGEN(b.x)], 1u);
            asm volatile("s_waitcnt vmcnt(0)" ::: "memory");
        } else {
            __builtin_amdgcn_fence(__ATOMIC_ACQUIRE, "agent");
            XB_SPIN(xb_ld(&bar[XB_XGEN(b.x)]) == gen, bar);
            asm volatile("s_waitcnt vmcnt(0)" ::: "memory");
        }
    }
    __syncthreads();
}


constexpr int PH_PER_LAYER = 13, N_PHASES = 2 * PH_PER_LAYER + 1;
__global__ void __launch_bounds__(512) fwd_kernel(Params p) {
    extern __shared__ __attribute__((aligned(16))) unsigned char lds_raw[];
    LAS unsigned char* lds = (LAS unsigned char*)lds_raw;
    cg::grid_group grid = cg::this_grid();
    if (threadIdx.x < 64) ((LAS unsigned*)(lds + 131072))[threadIdx.x] = 0u;
    __syncthreads();
    XcdBarrier xbar = xcd_barrier_post((unsigned*)(kparams()->ws + WS_CTL), (volatile LAS unsigned*)(lds + 131072 + 64));
    for (int ph = p.ph_lo; ph < p.ph_hi; ++ph) {
        KP kp = kparams();
        unsigned char* ws = kp->ws;
        const int l_ = ph / PH_PER_LAYER;
        bf16_t* Z = (bf16_t*)(ws + ws_big(l_)); bf16_t* XB = (bf16_t*)(ws + ws_xb(l_));
        float* ssqA = (float*)(ws + WS_SSQA); float* ssqB = (float*)(ws + WS_SSQB);
        const int l = ph / PH_PER_LAYER, k = ph % PH_PER_LAYER;
        if (ph == N_PHASES - 1) { final_phase(kp, ssqA, (const bf16_t*)(ws + ws_big(1) + 96 * MiB)); break; }
        float* sa = (l == 0) ? ssqA : ssqB; float* sb = (l == 0) ? ssqB : ssqA;
        bool is_gemm = false;
        Sched S; Epi E;
        S.nsub = 1; S.nN = 4; S.G = gridDim.x; S.c = blockIdx.x;
        S.s0 = SubG{nullptr, nullptr, D, D, D, MODE_RES, 0, 1 << 30, 0}; S.s1 = S.s0;
        E.Z = Z; E.out16 = Z; E.ld16 = NIN; E.ssq_in = sa; E.ssq_out = sb; E.ssqv = (float*)(ws + WS_SSQV);
        E.xin16 = XB; E.xout16 = XB; E.pool_scale = kp->in[I_PSCALE] + l * D; E.C16 = (bf16_t*)(ws + ws_big(l) + 8 * MiB);
        switch (k) {
        case 0: prep_phase(kp, lds, l); break;
        case 1: S.nN = 20; S.s0 = SubG{XB, (const bf16_t*)(ws + W_IN), D, D, D, MODE_IN, 0, 1 << 30, 0}; E.ssq_in = sa; is_gemm = true; break;
        case 2: sgu_phase(kp, lds, l); break;
        case 3: break;
        case 4: S.nN = 4; S.s0 = SubG{Z + 2048, (const bf16_t*)(ws + W_POOL), NIN, 256, 256, MODE_POOL, 256, 1 << 30, 0}; is_gemm = true; break;
        case 5: S.nN = 4; S.nsub = 2; S.s0 = SubG{Z, (const bf16_t*)(ws + W_A), NIN, D, D, MODE_YA, 0, 1 << 30, 0};
                S.s1 = SubG{Z + 1024, (const bf16_t*)(ws + W_B), NIN, D, D, MODE_YB, 0, 1 << 30, 0}; is_gemm = true; break;
        case 6: S.nN = 4; S.s0 = SubG{Z + 4096, (const bf16_t*)(ws + W_O), NIN, D, D, MODE_RES, 0, 1 << 30, 0};
                E.ssq_out = sb; is_gemm = true; break;
        case 7: S.nN = 12; S.s0 = SubG{XB, (const bf16_t*)(ws + W_UP), D, D, D, MODE_UP, 0, 6, 5}; E.ssq_in = sb; E.out16 = (bf16_t*)(ws + ws_big(l)); E.ld16 = 3072; is_gemm = true; break;
        case 8: conv_phase(kp, l, 0, 6); break;
        case 9: S.nN = 10; S.s0 = SubG{XB, (const bf16_t*)(ws + W_UP) + (size_t)6 * 256 * D, D, D, D, MODE_UP, 0, 5, 6}; E.ssq_in = sb; E.out16 = (bf16_t*)(ws + ws_big(l)); E.ld16 = 2560; is_gemm = true; break;
        case 10: conv_phase(kp, l, 6, 5); break;
        case 11:
                 S.nN = 4; S.s0 = SubG{(const bf16_t*)(ws + ws_big(l) + 96 * MiB), (const bf16_t*)(ws + W_DN), FF, FF, FF, MODE_RES, 0, 1 << 30, 0}; E.ssq_out = sa; is_gemm = true; break;
        case 12: S.nN = 4; S.nsub = 2; S.s0 = SubG{(const bf16_t*)(ws + ws_big(l) + 80 * MiB), (const bf16_t*)(ws + W_PLE), PLE, PLE, PLE, MODE_E, 0, 1 << 30, 0};
                 S.s1 = SubG{XB, (const bf16_t*)(ws + W_PG), D, D, D, MODE_PLE, 0, 1 << 30, 0}; E.ssq_in = sa; E.ssq_out = sb; E.xout16 = (l == 0) ? (bf16_t*)(ws + ws_xb(1)) : (bf16_t*)(ws + ws_big(1) + 96 * MiB); is_gemm = true; break;
        }
        const bool side_first = (k == 9) ? true : (((blockIdx.x >> 3) & 1) != 0);
#define SIDE_WORK() do { \
        if (k == 4) prep_weights(kp, lds, l, WM_A | WM_B | WM_O, 0, gridDim.x); \
        if (k == 6) prep_weights(kp, lds, l, WM_UP, 0, gridDim.x); \
        if (k == 9) { const int G = gridDim.x; prep_weights(kp, lds, l, WM_DN | WM_PG | WM_PLE, G / 2, G - G / 2); pb_convert(kp, l, G / 2, G - G / 2); } } while (0)
        if (side_first && (k == 4 || k == 6 || k == 9)) { SIDE_WORK(); asm volatile("s_waitcnt lgkmcnt(0)" ::: "memory"); __syncthreads(); }
        if (is_gemm) gemm_phase(lds, S, E);
        if (!side_first && (k == 4 || k == 6 || k == 9)) SIDE_WORK();
#undef SIDE_WORK
        if (ph + 1 < p.ph_hi && k != 3) { xcd_barrier(xbar); if (p.ph_lo < 0) grid.sync(); }
    }
}

extern "C" void kernel_launch(void* const* d_in, const int* in_sizes, int n_in, void* d_out, int out_size, void* d_ws, size_t ws_size, hipStream_t stream) {
    static int grid = 0;
    if (grid == 0) {
        if (n_in != 21 || out_size != M * D || ws_size < WS_END) { fprintf(stderr, "kernel_launch: unexpected problem (n_in %d out %d ws %zu)\n", n_in, out_size, ws_size); grid = -1; return; }
        int dev = 0, cus = 0, per_cu = 0;
        hipGetDevice(&dev); hipDeviceGetAttribute(&cus, hipDeviceAttributeMultiprocessorCount, dev);
        if (hipFuncSetAttribute((const void*)fwd_kernel, hipFuncAttributeMaxDynamicSharedMemorySize, LDS_BYTES) != hipSuccess) { fprintf(stderr, "kernel_launch: hipFuncSetAttribute failed\n"); grid = -1; return; }
        if (hipOccupancyMaxActiveBlocksPerMultiprocessor(&per_cu, (const void*)fwd_kernel, 512, LDS_BYTES) != hipSuccess || per_cu < 1) { fprintf(stderr, "kernel_launch: occupancy query %d\n", per_cu); per_cu = 1; }
        (void)hipGetLastError();
        grid = cus * (per_cu > 1 ? 1 : per_cu);
    }
    if (grid < 0) return;
    if (hipMemsetAsync((char*)d_ws + WS_CTL, 0, CTL_BYTES, stream) != hipSuccess) { fprintf(stderr, "kernel_launch: memset failed\n"); return; }
    Params p{};
    for (int i = 0; i < 21; ++i) p.in[i] = (const float*)d_in[i];
    p.out = (float*)d_out; p.ws = (unsigned char*)d_ws; p.ph_lo = 0; p.ph_hi = N_PHASES;
    void* args[] = {&p};
    hipError_t e = hipLaunchCooperativeKernel((const void*)fwd_kernel, dim3(grid), dim3(512), args, LDS_BYTES, stream);
    if (e != hipSuccess) fprintf(stderr, "cooperative launch failed: %s (grid %d)\n", hipGetErrorString(e), grid);
}
```
